# Optimizing an MI355X kernel written in HIP

```python
import math
import jax, jax.numpy as jnp
from jax import lax
import numpy as np

D_MODEL = 1024
BATCH = 8
SEQ = 2048
DEPTH = 1

HEAD_DIM = 64
HEADS_PER_GROUP = 8
ATTN_GROUPS = ((128, 1), (512, 4), (2048, 16))
N_ATTN_GROUPS = len(ATTN_GROUPS)
ATTN_WIDTH = HEADS_PER_GROUP * HEAD_DIM
Q_BLOCK = 128
ROPE_THETA = 500000.0
ROPE_DIMS = HEAD_DIM // 4
GMLP_WIDTH = 512
GMLP_GROUPS = 8
GMLP_GROUP_DIM = GMLP_WIDTH // GMLP_GROUPS
CHUNK = 128
EPS = 1e-6

QKV_COLS = N_ATTN_GROUPS * 3 * ATTN_WIDTH
OFF_GATE_A = QKV_COLS
OFF_Z_B = OFF_GATE_A + ATTN_WIDTH
OFF_GATE_B = OFF_Z_B + 2 * GMLP_WIDTH
OFF_MERGE_A = OFF_GATE_B + GMLP_WIDTH
OFF_MERGE_B = OFF_MERGE_A + D_MODEL
IN_COLS = OFF_MERGE_B + D_MODEL

kernel_name = "hybrid_dilated_attn_gmlp_block"


def rms_norm(x, g):
    xf = x.astype(jnp.float32)
    y = xf * lax.rsqrt(jnp.mean(xf * xf, axis=-1, keepdims=True) + EPS)
    return (y * g.astype(jnp.float32)).astype(x.dtype)


def layer_norm(x, g, b):
    xf = x.astype(jnp.float32)
    mu = jnp.mean(xf, axis=-1, keepdims=True)
    var = jnp.mean(jnp.square(xf - mu), axis=-1, keepdims=True)
    y = (xf - mu) * lax.rsqrt(var + EPS) * g.astype(jnp.float32) + b.astype(jnp.float32)
    return y.astype(x.dtype)


def partial_rope(x, positions):
    half = ROPE_DIMS // 2
    freqs = ROPE_THETA ** (-jnp.arange(0, ROPE_DIMS, 2, dtype=jnp.float32) / ROPE_DIMS)
    ang = positions.astype(jnp.float32)[..., None] * freqs
    cos = jnp.cos(ang)[:, :, None, :]
    sin = jnp.sin(ang)[:, :, None, :]
    xf = x.astype(jnp.float32)
    x1 = xf[..., :half]
    x2 = xf[..., half:ROPE_DIMS]
    rot = jnp.concatenate([x1 * cos - x2 * sin, x2 * cos + x1 * sin, xf[..., ROPE_DIMS:]], axis=-1)
    return rot.astype(x.dtype)


def dilated_window_attention(q, k, v, window, dilation):
    B, S, H, E = q.shape
    n_back = window // dilation
    L = S // dilation
    n_blk = -(-L // Q_BLOCK)
    Lp = n_blk * Q_BLOCK
    kb_len = Q_BLOCK + n_back
    qr = q.astype(jnp.float32).reshape(B, L, dilation, H, E)
    kr = k.astype(jnp.float32).reshape(B, L, dilation, H, E)
    vr = v.astype(jnp.float32).reshape(B, L, dilation, H, E)
    qp = jnp.pad(qr, ((0, 0), (0, Lp - L), (0, 0), (0, 0), (0, 0)))
    qb = qp.reshape(B, n_blk, Q_BLOCK, dilation, H, E)
    pad_k = ((0, 0), (n_back, Lp - L), (0, 0), (0, 0), (0, 0))
    kp = jnp.pad(kr, pad_k)
    vp = jnp.pad(vr, pad_k)
    idx = (jnp.arange(n_blk) * Q_BLOCK)[:, None] + jnp.arange(kb_len)[None, :]
    kb = kp[:, idx]
    vb = vp[:, idx]
    s = jnp.einsum('bnqrhe,bnkrhe->brhnqk', qb, kb) * (1.0 / math.sqrt(E))
    qq = jnp.arange(Q_BLOCK)[:, None]
    kk = jnp.arange(kb_len)[None, :]
    blk = jnp.arange(n_blk)[:, None, None]
    diff = qq + n_back - kk
    key_m = blk * Q_BLOCK - n_back + kk
    valid = (diff >= 0) & (diff <= n_back) & (key_m >= 0)
    s = jnp.where(valid, s, -jnp.inf)
    m = jnp.max(s, axis=-1, keepdims=True)
    p = jnp.exp(s - m)
    den = jnp.sum(p, axis=-1)
    lse = m[..., 0] + jnp.log(den)
    o = jnp.einsum('brhnqk,bnkrhe->bnqrhe', p, vb)
    o = o / jnp.transpose(den, (0, 3, 4, 1, 2))[..., None]
    o = o.reshape(B, Lp, dilation, H, E)[:, :L].reshape(B, S, H, E)
    lse = jnp.transpose(lse, (0, 3, 4, 1, 2)).reshape(B, Lp, dilation, H)[:, :L].reshape(B, S, H)
    return o, lse


def setup_inputs(seed: int = 0) -> dict:
    key = jax.random.key(seed)
    ks = jax.random.split(key, 16)
    D = D_MODEL
    f32 = jnp.float32
    x = jax.random.normal(ks[0], (BATCH, SEQ, D), f32)
    c = jax.random.normal(ks[1], (BATCH, D), f32)
    offs = jax.random.randint(ks[2], (BATCH, 1), 0, 1024, dtype=jnp.int32)
    positions = offs + jnp.arange(SEQ, dtype=jnp.int32)[None, :]
    norm_g = 1.0 + 0.02 * jax.random.normal(ks[3], (D,), f32)
    w_ada = 0.2 * jax.random.normal(ks[4], (D, 3 * D), f32) * D ** -0.5
    b_ada = 0.02 * jax.random.normal(ks[5], (3 * D,), f32)
    w_in = jax.random.normal(ks[6], (D, IN_COLS), f32) * D ** -0.5
    q_norm_g = 1.0 + 0.02 * jax.random.normal(ks[7], (N_ATTN_GROUPS, HEAD_DIM), f32)
    k_norm_g = 1.0 + 0.02 * jax.random.normal(ks[8], (N_ATTN_GROUPS, HEAD_DIM), f32)
    sgu_ln_g = 1.0 + 0.02 * jax.random.normal(ks[9], (GMLP_WIDTH,), f32)
    sgu_ln_b = 0.02 * jax.random.normal(ks[10], (GMLP_WIDTH,), f32)
    w_spatial = 0.5 * jax.random.normal(ks[11], (GMLP_GROUPS, CHUNK, CHUNK), f32) * CHUNK ** -0.5
    b_spatial = 1.0 + 0.02 * jax.random.normal(ks[12], (GMLP_GROUPS, CHUNK), f32)
    w_branch_a = jax.random.normal(ks[13], (ATTN_WIDTH, D), f32) * ATTN_WIDTH ** -0.5
    w_branch_b = jax.random.normal(ks[14], (GMLP_WIDTH, D), f32) * GMLP_WIDTH ** -0.5
    w_out = jax.random.normal(ks[15], (D, D), f32) * D ** -0.5
    return {"x": x, "c": c, "positions": positions, "norm_g": norm_g,
            "w_ada": w_ada, "b_ada": b_ada, "w_in": w_in,
            "q_norm_g": q_norm_g, "k_norm_g": k_norm_g,
            "sgu_ln_g": sgu_ln_g, "sgu_ln_b": sgu_ln_b,
            "w_spatial": w_spatial, "b_spatial": b_spatial,
            "w_branch_a": w_branch_a, "w_branch_b": w_branch_b, "w_out": w_out}


def reference(x, c, positions, norm_g, w_ada, b_ada, w_in, q_norm_g, k_norm_g,
              sgu_ln_g, sgu_ln_b, w_spatial, b_spatial, w_branch_a, w_branch_b, w_out):
    B, S, D = x.shape
    causal_chunk = jnp.tril(jnp.ones((CHUNK, CHUNK), dtype=bool))
    for layer in range(DEPTH):
        ada = jax.nn.silu(c) @ w_ada + b_ada
        shift, scale, gate = jnp.split(ada, 3, axis=-1)
        h = rms_norm(x, norm_g) * (1.0 + scale[:, None, :]) + shift[:, None, :]

        z = h @ w_in
        qkv = z[..., :QKV_COLS].reshape(B, S, N_ATTN_GROUPS, 3, HEADS_PER_GROUP, HEAD_DIM)

        outs, lses = [], []
        for g, (window, dilation) in enumerate(ATTN_GROUPS):
            q = partial_rope(rms_norm(qkv[:, :, g, 0], q_norm_g[g]), positions)
            k = partial_rope(rms_norm(qkv[:, :, g, 1], k_norm_g[g]), positions)
            v = qkv[:, :, g, 2]
            o, lse = dilated_window_attention(q, k, v, window, dilation)
            outs.append(o)
            lses.append(lse)
        o_all = jnp.stack(outs, axis=0)
        w_grp = jax.nn.softmax(jnp.stack(lses, axis=0), axis=0)
        attn = jnp.sum(w_grp[..., None] * o_all, axis=0).reshape(B, S, ATTN_WIDTH).astype(x.dtype)
        y_a = attn * jax.nn.silu(z[..., OFF_GATE_A:OFF_Z_B])

        uv = jax.nn.gelu(z[..., OFF_Z_B:OFF_GATE_B], approximate=False)
        u, v = jnp.split(uv, 2, axis=-1)
        v = layer_norm(v, sgu_ln_g, sgu_ln_b)
        n_chunks = S // CHUNK
        vc = v.reshape(B, n_chunks, CHUNK, GMLP_GROUPS, GMLP_GROUP_DIM)
        w_s = jnp.where(causal_chunk[None], w_spatial, 0.0)
        sv = jnp.einsum('gts,bnsgc->bntgc', w_s, vc) + b_spatial.T[None, None, :, :, None]
        y_b = u * sv.reshape(B, S, GMLP_WIDTH)
        y_b = y_b * jax.nn.silu(z[..., OFF_GATE_B:OFF_MERGE_A])

        merged = (jax.nn.sigmoid(z[..., OFF_MERGE_A:OFF_MERGE_B]) * (y_a @ w_branch_a)
                  + jax.nn.sigmoid(z[..., OFF_MERGE_B:IN_COLS]) * (y_b @ w_branch_b))
        out = merged @ w_out
        x = x + gate[:, None, :] * out
    return x
```

```cpp
#include <hip/hip_runtime.h>
#include <cstdio>
#include <cstdint>
#include <cmath>
namespace pg8 {
#define PG8_LAS __attribute__((address_space(3)))
typedef unsigned short bf16_t;
typedef short bf16x8 __attribute__((ext_vector_type(8)));
typedef float f32x4 __attribute__((ext_vector_type(4)));
typedef unsigned u32x4 __attribute__((ext_vector_type(4)));
constexpr int BM = 256, BK = 64, HALF = 128, HTB = HALF * BK * 2  , STAGE_BYTES = 8 * HTB, NXCD = 8, WGM = 8;

__host__ __device__ __forceinline__ int lds_byte(int r, int c) { const int st = (r >> 4) * 2 + (c >> 5), rr = r & 15, cc = c & 31, ob = rr * 64 + cc * 2; return st * 1024 + (ob ^ (((ob >> 9) & 1) << 5)); }
__host__ __device__ __forceinline__ void stage_rc(int b, int& R, int& C) { const int st = b / 1024, sb = b % 1024, swz = sb ^ (((sb >> 9) & 1) << 5); R = (st >> 1) * 16 + swz / 64; C = (st & 1) * 32 + (swz % 64) / 2; }
__host__ __device__ __forceinline__ int perm32(int rho) { const int n = rho >> 4, i = rho & 15; return 8 * (i >> 2) + 4 * n + (i & 3); }

struct Unit { int pm, pn; };
struct Gemm { const bf16_t* A; const bf16_t* Bt; int M, N, K; };

struct StaticOrder {
    int nM, nN, nwg, G, c;
    __host__ __device__ void init(int M, int N, int G_, int c_) { nM = M / BM; nN = N / BM; nwg = nM * nN; G = G_; c = c_; }
    __host__ __device__ bool next(int i, Unit& u) const {
        const long L = (long)i * G + c; if (L >= nwg) return false;
        int wgid = (int)L; { const int q = nwg / NXCD, r = nwg % NXCD, xcd = wgid % NXCD, off = wgid / NXCD; wgid = (xcd < r ? xcd * (q + 1) : r * (q + 1) + (xcd - r) * q) + off; }
        const int nig = WGM * nN, gid = wgid / nig, fm = gid * WGM, gsz = (nM - fm) < WGM ? (nM - fm) : WGM;
        u.pm = fm + ((wgid % nig) % gsz); u.pn = (wgid % nig) / gsz; return true;
    }
    __device__ __forceinline__ void a_ready(const Unit&) const {}
    __device__ __forceinline__ void done(const Unit&) const {}
};

typedef float cvt_f32x2_t __attribute__((ext_vector_type(2))); typedef __bf16 cvt_bf16x2_t __attribute__((ext_vector_type(2)));
__device__ __forceinline__ unsigned cvt_pk_bf16(float lo, float hi) { const cvt_f32x2_t v = {lo, hi}; const cvt_bf16x2_t b = __builtin_convertvector(v, cvt_bf16x2_t); return __builtin_bit_cast(unsigned, b); }
typedef float f32x2 __attribute__((ext_vector_type(2)));
__device__ __forceinline__ f32x2 gelu_pk(f32x2 v) {
    const f32x2 av = __builtin_elementwise_abs(v), d = av * 0.2316418882f + 1.0f;
    f32x2 t; t.x = __builtin_amdgcn_rcpf(d.x); t.y = __builtin_amdgcn_rcpf(d.y);
    f32x2 q = t * 0.5307027145f + (-0.7265760135f); q = q * t + 0.7107068705f; q = q * t + (-0.142248368f); q = q * t + 0.127414796f; q = q * t;
    const f32x2 s = (v * v) * (-0.72134752044f);
    f32x2 e; e.x = __builtin_amdgcn_exp2f(s.x); e.y = __builtin_amdgcn_exp2f(s.y);
    const f32x2 m = v * (q * e), r = v - m;
    f32x2 o; o.x = v.x < 0.f ? m.x : r.x; o.y = v.y < 0.f ? m.y : r.y; return o;
}
template <int ACT  > struct EpiBf16 {
    static constexpr bool PERM = true, AFTER_DRAIN = false; static_assert(ACT == 0 || ACT == 1, "EpiBf16: ACT is 0 (none) or 1 (gelu_pk)");
    bf16_t* O; int ldc; const float* bias; int split_cols; size_t split_stride; float scale0;
    __device__ __forceinline__ void operator()(const f32x4 (&acc)[2][2][4][2], const Unit& u, int wr, int wc, int fr, int fq) const {
        const int row0 = u.pm * BM + wr * 64 + fr; int colt = u.pn * BM; bf16_t* base = O;
        float sc = 1.f; if (split_cols) { const int t = colt / split_cols; base += (size_t)t * split_stride; colt -= t * split_cols; if (t == 0) sc = scale0; }
        const int col0 = colt + wc * 32 + 8 * fq, bcol0 = u.pn * BM + wc * 32 + 8 * fq;
        f32x4 bv[2][2];
#pragma unroll
        for (int bj = 0; bj < 2; ++bj)
#pragma unroll
            for (int n = 0; n < 2; ++n) bv[bj][n] = bias ? *(const f32x4*)(bias + bcol0 + bj * HALF + 4 * n) : (f32x4){0.f, 0.f, 0.f, 0.f};
#pragma unroll
        for (int ai = 0; ai < 2; ++ai)
#pragma unroll
            for (int m = 0; m < 4; ++m) { bf16_t* rowp = base + (size_t)(row0 + ai * HALF + m * 16) * ldc + col0;
#pragma unroll
                for (int bj = 0; bj < 2; ++bj) { f32x4 v0 = acc[ai][bj][m][0] + bv[bj][0], v1 = acc[ai][bj][m][1] + bv[bj][1];
                    if (ACT == 1) { f32x2 a = gelu_pk((f32x2){v0[0], v0[1]}), b = gelu_pk((f32x2){v0[2], v0[3]}), c = gelu_pk((f32x2){v1[0], v1[1]}), d = gelu_pk((f32x2){v1[2], v1[3]});
                        v0 = (f32x4){a.x, a.y, b.x, b.y}; v1 = (f32x4){c.x, c.y, d.x, d.y}; }
                    v0 = v0 * sc; v1 = v1 * sc; u32x4 w; w.x = cvt_pk_bf16(v0[0], v0[1]); w.y = cvt_pk_bf16(v0[2], v0[3]); w.z = cvt_pk_bf16(v1[0], v1[1]); w.w = cvt_pk_bf16(v1[2], v1[3]);
                    *(u32x4*)(rowp + bj * HALF) = w; } }
    }
};

template <class Epi, class Sched, bool ALIGN_EPI = false, bool SP2 = false>
__device__ __forceinline__ void gemm_phase(PG8_LAS unsigned char* lds, const Gemm g, const Sched& S, const Epi& E) {
    const int tid = threadIdx.x, wid = __builtin_amdgcn_readfirstlane(tid >> 6), lane = tid & 63, wr = wid >> 2, wc = wid & 3, fr = lane & 15, fq = lane >> 4;
    const int K = g.K, nt = K / BK;
    unsigned voffA[2], voffB[2];
#pragma unroll
    for (int i = 0; i < 2; ++i) { int R, C; stage_rc(tid * 16 + i * 8192, R, C); const int Rb = Epi::PERM ? ((R & ~31) + perm32(R & 31)) : R;
        voffA[i] = (unsigned)(R * K + C) * 2u; voffB[i] = (unsigned)(Rb * K + C) * 2u; }
    const size_t kstep = (size_t)(BK * 2);
    const size_t hstep = (size_t)HALF * K * 2;
    const size_t tstep = 2 * hstep;
    const unsigned ldsw = (unsigned)wid * 1024u;
    const int aoff = lds_byte(wr * 64 + fr, fq * 8), boff = lds_byte(wc * 32 + fr, fq * 8);
#define PG8_SA(b, h) (((b) * 2 + (h)) * HTB)
#define PG8_SB(b, h) ((4 + (b) * 2 + (h)) * HTB)
#define PG8_STAGE(bufoff, gbase, voff) do { _Pragma("unroll") for (int _i = 0; _i < 2; ++_i) \
        __builtin_amdgcn_global_load_lds((const unsigned*)((const char*)(gbase) + (voff)[_i]), (PG8_LAS unsigned*)(lds + (bufoff) + ldsw + _i * 8192), 16, 0, 0); } while (0)
#define PG8_LDA(dst, b, h) do { _Pragma("unroll") for (int m = 0; m < 4; ++m) _Pragma("unroll") for (int k = 0; k < 2; ++k) dst[m][k] = *(const PG8_LAS bf16x8*)(lds + PG8_SA(b, h) + aoff + m * 2048 + k * 1024); } while (0)
#define PG8_LDB(dst, b, h) do { _Pragma("unroll") for (int n = 0; n < 2; ++n) _Pragma("unroll") for (int k = 0; k < 2; ++k) dst[n][k] = *(const PG8_LAS bf16x8*)(lds + PG8_SB(b, h) + boff + n * 2048 + k * 1024); } while (0)
#define PG8_MMA(ai, bj, At, Bt) do { __builtin_amdgcn_s_setprio(1); _Pragma("unroll") for (int m = 0; m < 4; ++m) _Pragma("unroll") for (int n = 0; n < 2; ++n) _Pragma("unroll") for (int k = 0; k < 2; ++k) \
        acc[ai][bj][m][n] = __builtin_amdgcn_mfma_f32_16x16x32_bf16(Bt[n][k], At[m][k], acc[ai][bj][m][n], 0, 0, 0); __builtin_amdgcn_s_setprio(0); } while (0)
#define PG8_WAIT_V(n) asm volatile("s_waitcnt vmcnt(" #n ")" ::: "memory")
#define PG8_WAIT_L(n) asm volatile("s_waitcnt lgkmcnt(" #n ")" ::: "memory")
#define PG8_BAR __builtin_amdgcn_s_barrier()
#define PG8_SCHED __builtin_amdgcn_sched_barrier(0)
    Unit cur, nxt; int ui = 0;
    if (!S.next(0, cur)) return;
    f32x4 acc[2][2][4][2];
#pragma unroll
    for (int a = 0; a < 2; ++a)
#pragma unroll
        for (int b = 0; b < 2; ++b)
#pragma unroll
            for (int m = 0; m < 4; ++m)
#pragma unroll
                for (int n = 0; n < 2; ++n) acc[a][b][m][n] = (f32x4){0.f, 0.f, 0.f, 0.f};
    bf16x8 At[4][2], B0[2][2], B1[2][2];
    const char* cA = (const char*)g.A + (size_t)cur.pm * tstep; const char* cB = (const char*)g.Bt + (size_t)cur.pn * tstep;
    S.a_ready(cur);
    if constexpr (SP2) {
        PG8_STAGE(PG8_SB(0, 0), cB, voffB); PG8_STAGE(PG8_SB(0, 1), cB + hstep, voffB); PG8_STAGE(PG8_SA(0, 0), cA, voffA); PG8_STAGE(PG8_SA(0, 1), cA + hstep, voffA);
        if (wr == 1) PG8_BAR;
        PG8_WAIT_V(2); PG8_BAR;
        PG8_STAGE(PG8_SB(1, 0), cB + kstep, voffB); PG8_STAGE(PG8_SA(1, 0), cA + kstep, voffA); PG8_STAGE(PG8_SB(1, 1), cB + hstep + kstep, voffB);
        PG8_WAIT_V(6); PG8_BAR;
    } else {
        PG8_STAGE(PG8_SB(0, 0), cB, voffB); PG8_STAGE(PG8_SA(0, 0), cA, voffA); PG8_STAGE(PG8_SB(0, 1), cB + hstep, voffB); PG8_STAGE(PG8_SA(0, 1), cA + hstep, voffA);
        if (wr == 1) PG8_BAR;
        PG8_WAIT_V(4); PG8_BAR;
        PG8_STAGE(PG8_SB(1, 0), cB + kstep, voffB); PG8_STAGE(PG8_SA(1, 0), cA + kstep, voffA); PG8_STAGE(PG8_SB(1, 1), cB + hstep + kstep, voffB);
        PG8_WAIT_V(6); PG8_BAR;
    }
    for (;;) {
        const bool has_next = S.next(ui + 1, nxt);
        const char* nA = has_next ? (const char*)g.A + (size_t)nxt.pm * tstep : cA; const char* nB = has_next ? (const char*)g.Bt + (size_t)nxt.pn * tstep : cB;
        for (int t = 0; t < nt; t += 2) {
            const bool last = (t == nt - 2);
            const char* a1 = cA + (size_t)(t + 1) * kstep;
            const char* a2 = last ? nA : cA + (size_t)(t + 2) * kstep; const char* b2 = last ? nB : cB + (size_t)(t + 2) * kstep;
            const char* a3 = a2 + kstep; const char* b3 = b2 + kstep;
            if (last && has_next) S.a_ready(nxt);
            if constexpr (SP2) {
            PG8_LDB(B0, 0, 0); PG8_LDB(B1, 0, 1); PG8_SCHED; PG8_LDA(At, 0, 0); PG8_STAGE(PG8_SA(1, 1), a1 + hstep, voffA);
            PG8_WAIT_V(8); PG8_WAIT_L(0); PG8_BAR; PG8_MMA(0, 0, At, B0); PG8_MMA(0, 1, At, B1); PG8_BAR; PG8_SCHED;
            PG8_LDA(At, 0, 1); PG8_STAGE(PG8_SB(0, 0), b2, voffB); PG8_STAGE(PG8_SB(0, 1), b2 + hstep, voffB); PG8_STAGE(PG8_SA(0, 0), a2, voffA);
            PG8_WAIT_V(8); PG8_WAIT_L(0); PG8_BAR; PG8_MMA(1, 0, At, B0); PG8_MMA(1, 1, At, B1); PG8_BAR; PG8_SCHED;
            PG8_LDB(B0, 1, 0); PG8_LDB(B1, 1, 1); PG8_SCHED; PG8_LDA(At, 1, 0); PG8_STAGE(PG8_SA(0, 1), a2 + hstep, voffA);
            PG8_WAIT_V(8); PG8_WAIT_L(0); PG8_BAR; PG8_MMA(0, 0, At, B0); PG8_MMA(0, 1, At, B1); PG8_BAR; PG8_SCHED;
            PG8_LDA(At, 1, 1); PG8_STAGE(PG8_SB(1, 0), b3, voffB); PG8_STAGE(PG8_SB(1, 1), b3 + hstep, voffB); PG8_STAGE(PG8_SA(1, 0), a3, voffA);
            PG8_WAIT_V(8); PG8_WAIT_L(0); PG8_BAR; PG8_MMA(1, 0, At, B0); PG8_MMA(1, 1, At, B1); PG8_BAR; PG8_SCHED;
            } else {
            PG8_LDB(B0, 0, 0); PG8_SCHED; PG8_LDA(At, 0, 0); PG8_STAGE(PG8_SA(1, 1), a1 + hstep, voffA);
            PG8_WAIT_L(8); PG8_BAR; PG8_WAIT_L(0); PG8_MMA(0, 0, At, B0); PG8_BAR; PG8_SCHED;
            PG8_LDB(B1, 0, 1); PG8_STAGE(PG8_SB(0, 0), b2, voffB);
            PG8_BAR; PG8_WAIT_L(0); PG8_MMA(0, 1, At, B1); PG8_BAR;
            PG8_LDA(At, 0, 1); PG8_STAGE(PG8_SA(0, 0), a2, voffA);
            PG8_BAR; PG8_WAIT_L(0); PG8_MMA(1, 0, At, B0); PG8_BAR; PG8_SCHED;
            PG8_STAGE(PG8_SB(0, 1), b2 + hstep, voffB);
            PG8_WAIT_V(6); PG8_BAR; PG8_MMA(1, 1, At, B1); PG8_BAR;
            PG8_LDB(B0, 1, 0); PG8_SCHED; PG8_LDA(At, 1, 0); PG8_STAGE(PG8_SA(0, 1), a2 + hstep, voffA);
            PG8_WAIT_L(8); PG8_BAR; PG8_WAIT_L(0); PG8_MMA(0, 0, At, B0); PG8_BAR; PG8_SCHED;
            PG8_LDB(B1, 1, 1); PG8_STAGE(PG8_SB(1, 0), b3, voffB);
            PG8_BAR; PG8_WAIT_L(0); PG8_MMA(0, 1, At, B1); PG8_BAR;
            PG8_LDA(At, 1, 1); PG8_STAGE(PG8_SA(1, 0), a3, voffA);
            PG8_BAR; PG8_WAIT_L(0); PG8_MMA(1, 0, At, B0); PG8_BAR; PG8_SCHED;
            PG8_STAGE(PG8_SB(1, 1), b3 + hstep, voffB);
            PG8_WAIT_V(6); PG8_BAR; PG8_MMA(1, 1, At, B1); PG8_BAR;
            }
        }
        if constexpr (ALIGN_EPI) { if (wr == 0) PG8_BAR; }
        if constexpr (!Epi::AFTER_DRAIN) { E(acc, cur, wr, wc, fr, fq); S.done(cur); }
        if (!has_next) break;
#pragma unroll
        for (int a = 0; a < 2; ++a)
#pragma unroll
            for (int b = 0; b < 2; ++b)
#pragma unroll
                for (int m = 0; m < 4; ++m)
#pragma unroll
                    for (int n = 0; n < 2; ++n) acc[a][b][m][n] = (f32x4){0.f, 0.f, 0.f, 0.f};
        cur = nxt; cA = nA; cB = nB; ++ui;
        if constexpr (ALIGN_EPI) { if (wr == 1) PG8_BAR; }
    }
    PG8_WAIT_V(0);
    if constexpr (!ALIGN_EPI) { if (wr == 0) PG8_BAR; }
    PG8_BAR;
    if constexpr (Epi::AFTER_DRAIN) { E.fused(acc, cur, wr, wc, fr, fq, lds, wid, lane); S.done(cur); }
#undef PG8_SA
#undef PG8_SB
#undef PG8_STAGE
#undef PG8_LDA
#undef PG8_LDB
#undef PG8_MMA
#undef PG8_WAIT_V
#undef PG8_WAIT_L
#undef PG8_BAR
#undef PG8_SCHED
}
}
#define GAS __attribute__((address_space(1)))
#define LAS __attribute__((address_space(3)))
typedef unsigned short bf16;
typedef unsigned v4u __attribute__((ext_vector_type(4)));
typedef float f32x4 __attribute__((ext_vector_type(4)));
typedef short bf16x8 __attribute__((ext_vector_type(8)));
typedef GAS unsigned gu32;
typedef GAS unsigned long long gu64;
#define RLX_AGENT __ATOMIC_RELAXED, __HIP_MEMORY_SCOPE_AGENT
#define LDS_WAIT() asm volatile("s_waitcnt lgkmcnt(0)" ::: "memory")
#define VM_WAIT() asm volatile("s_waitcnt vmcnt(0)" ::: "memory")
__device__ __forceinline__ unsigned long long rt() { return __builtin_amdgcn_s_memrealtime(); }
__device__ __forceinline__ unsigned f2bf(float f) { unsigned u = __builtin_bit_cast(unsigned, f); return (u + 0x7fffu + ((u >> 16) & 1u)) >> 16; }
__device__ __forceinline__ unsigned pk2(float lo, float hi) { return f2bf(lo) | (f2bf(hi) << 16); }
#define XB_TMO      128
#define XB_XCNT(j)  (256  + 64 * (j))
#define XB_XSUB(j)  (1280 + 64 * (j))
#define XB_XGEN(j)  (2304 + 64 * (j))
#define XB_TOP      3328
#define XB_TOPGEN   3392
#define XCD_BAR_WORDS 3456
#define XB_SPIN_CAP (1u << 25)

__device__ __forceinline__ unsigned xb_ld(unsigned* p)              { return __hip_atomic_load(p, __ATOMIC_RELAXED, __HIP_MEMORY_SCOPE_AGENT); }
__device__ __forceinline__ unsigned xb_add(unsigned* p, unsigned v) { return __hip_atomic_fetch_add(p, v, __ATOMIC_RELAXED, __HIP_MEMORY_SCOPE_AGENT); }
__device__ __forceinline__ unsigned xb_xcc_id() { return (unsigned)__builtin_amdgcn_s_getreg((3 << 11) | 20) & 0xFu; }
#define XB_SPIN(cond, bar) do { unsigned _sp = 0; while (cond) { __builtin_amdgcn_s_sleep(1); \
    if ((++_sp & 255u) == 0u) { if (xb_ld(&(bar)[XB_TMO])) break; if (_sp > XB_SPIN_CAP) { atomicAdd(&(bar)[XB_TMO], 1u); break; } } } } while (0)

struct XcdBarrier {
    unsigned* bar; unsigned x;
    volatile LAS unsigned* st;
};

__device__ __forceinline__ XcdBarrier xcd_barrier_post(unsigned* bar, volatile LAS unsigned* st) {
    XcdBarrier b; b.bar = bar; b.x = xb_xcc_id(); b.st = st;
    if (threadIdx.x == 0) (void)xb_add(&bar[XB_XCNT(b.x)], 1u);
    return b;
}
__device__ __forceinline__ void xcd_barrier_complete(unsigned* bar, unsigned x, unsigned& nloc, unsigned& nx) {
    const unsigned G = gridDim.x * gridDim.y * gridDim.z;
    unsigned sum, cnt, mine, sp = 0u;
    for (;;) {
        sum = 0u; cnt = 0u; mine = 0u;
#pragma unroll
        for (unsigned j = 0; j < 16; ++j) { const unsigned c = xb_ld(&bar[XB_XCNT(j)]); sum += c; cnt += (c > 0u) ? 1u : 0u; mine = (j == x) ? c : mine; }
        if (sum == G) break;
        __builtin_amdgcn_s_sleep(1);
        if ((++sp & 255u) == 0u) { if (xb_ld(&bar[XB_TMO])) break; if (sp > XB_SPIN_CAP) { atomicAdd(&bar[XB_TMO], 1u); break; } }
    }
    nloc = mine > 0u ? mine : 1u; nx = cnt > 0u ? cnt : 1u;
}

__device__ __forceinline__ void xcd_barrier(const XcdBarrier& b) {
    asm volatile("s_waitcnt vmcnt(0)" ::: "memory");
    __syncthreads();
    if (threadIdx.x == 0) {
        unsigned* bar = b.bar;
        __builtin_amdgcn_s_waitcnt(0);
        unsigned nloc = b.st[0], nx = b.st[1];
        if (nloc == 0u) { xcd_barrier_complete(bar, b.x, nloc, nx); b.st[0] = nloc; b.st[1] = nx; }
        const unsigned old = xb_add(&bar[XB_XSUB(b.x)], 1u);
        const unsigned gen = old / nloc;
        if (old + 1u == (gen + 1u) * nloc) {
            __builtin_amdgcn_fence(__ATOMIC_RELEASE, "agent");
            asm volatile("s_waitcnt vmcnt(0)" ::: "memory");
            const unsigned og = xb_add(&bar[XB_TOP], 1u);
            const unsigned tg = og / nx;
            if (og + 1u == (tg + 1u) * nx) xb_add(&bar[XB_TOPGEN], 1u);
            else XB_SPIN(xb_ld(&bar[XB_TOPGEN]) == tg, bar);
            __builtin_amdgcn_fence(__ATOMIC_ACQUIRE, "agent");
            xb_add(&bar[XB_XGEN(b.x)], 1u);
            asm volatile("s_waitcnt vmcnt(0)" ::: "memory");
        } else {
            XB_SPIN(xb_ld(&bar[XB_XGEN(b.x)]) == gen, bar);
            __builtin_amdgcn_fence(__ATOMIC_ACQUIRE, "agent");
            asm volatile("s_waitcnt vmcnt(0)" ::: "memory");
        }
    }
    __syncthreads();
}

constexpr int NWAVES = 8;
#define MK_N_LAUNCHES 1
#ifndef MK_N_LAUNCHES
#define MK_N_LAUNCHES 1
#endif
constexpr int N_PHASES = 7;
constexpr int N_LAUNCHES = MK_N_LAUNCHES;
constexpr int BATCH = 8, SEQ = 2048, DM = 1024, MTOK = BATCH * SEQ, NIN = 8704;
constexpr float EPSN = 1e-6f, LOG2E = 1.4426950408889634f, LN2 = 0.6931471805599453f, QSCALE = 0.125f * 1.4426950408889634f;
constexpr size_t MiB = 1u << 20;
constexpr size_t WS_CTL = 0, CTL_ZERO_BYTES = 64 * 1024;
constexpr size_t WS_ADA = 1 * MiB;
constexpr size_t WS_MISC = 1 * MiB + 128 * 1024;
constexpr size_t WS_WSP = 1 * MiB + 256 * 1024;
constexpr size_t WS_LSE = 1 * MiB + 512 * 1024;
constexpr size_t WS_STATS = 3 * MiB;
constexpr size_t WS_ROPE = 4 * MiB;
constexpr size_t WS_WIN = 5 * MiB;
constexpr size_t WS_WA = 22 * MiB, WS_WB = 23 * MiB;
constexpr size_t WS_WOUT = 24 * MiB;
constexpr size_t WS_QKV = 26 * MiB;
constexpr size_t WS_GA = 170 * MiB;
constexpr size_t WS_UG = 186 * MiB;
constexpr size_t WS_VG = 202 * MiB;
constexpr size_t WS_MB = 218 * MiB;
constexpr size_t WS_MERGED = 26 * MiB;
constexpr size_t WS_TMP = 58 * MiB;
constexpr size_t WS_END = 250 * MiB;
constexpr size_t OUT_H = 0, OUT_MA = 32 * MiB;
constexpr int CW_BAR = 4096;
constexpr int LDSCTL_OFF = 139264, MISC_OFF = LDSCTL_OFF + 320, LDS_BYTES = 147456;

typedef float f32x2 __attribute__((ext_vector_type(2)));
typedef float f32x16 __attribute__((ext_vector_type(16)));
typedef short v4i16_t __attribute__((ext_vector_type(4)));
__device__ __forceinline__ float sigm(float x) { return __builtin_amdgcn_rcpf(1.f + __builtin_amdgcn_exp2f(-LOG2E * x)); }
__device__ __forceinline__ float siluf(float x) { return x * sigm(x); }
__device__ __forceinline__ float bflo(unsigned w) { return __builtin_bit_cast(float, w << 16); }
__device__ __forceinline__ float bfhi(unsigned w) { return __builtin_bit_cast(float, w & 0xffff0000u); }
__device__ __forceinline__ v4u pack8(f32x4 a, f32x4 b) { v4u w; w.x = pg8::cvt_pk_bf16(a[0], a[1]); w.y = pg8::cvt_pk_bf16(a[2], a[3]); w.z = pg8::cvt_pk_bf16(b[0], b[1]); w.w = pg8::cvt_pk_bf16(b[2], b[3]); return w; }
__device__ __forceinline__ f32x4 gelu4(f32x4 v) { const pg8::f32x2 a = pg8::gelu_pk((pg8::f32x2){v[0], v[1]}), b = pg8::gelu_pk((pg8::f32x2){v[2], v[3]}); return (f32x4){a.x, a.y, b.x, b.y}; }
__device__ __forceinline__ f32x4 silu4(f32x4 v) { return (f32x4){siluf(v[0]), siluf(v[1]), siluf(v[2]), siluf(v[3])}; }
__device__ __forceinline__ f32x4 sigm4(f32x4 v) { return (f32x4){sigm(v[0]), sigm(v[1]), sigm(v[2]), sigm(v[3])}; }

__host__ __device__ __forceinline__ int win_srccol(int np) {
    const int pn = np >> 8, j = np & 255;
    if (pn < 18) { const int g = pn / 6, t = (pn % 6) >> 1, half = pn & 1; return g * 1536 + t * 512 + half * 256 + 64 * ((j & 127) >> 5) + 32 * (j >> 7) + (j & 31); }
    if (pn < 20) return 4608 + (pn - 18) * 256 + j;
    if (pn < 24) return (j < 128) ? 5120 + 128 * (pn - 20) + j : 6144 + 128 * (pn - 20) + (j - 128);
    if (pn < 26) return 5632 + (pn - 24) * 256 + j;
    if (pn < 30) return 6656 + (pn - 26) * 256 + j;
    return 7680 + (pn - 30) * 256 + j;
}

struct EpiZ {
    static constexpr bool PERM = true, AFTER_DRAIN = false;
    bf16* qkv; bf16* ga; bf16* ug; bf16* vg; bf16* ma; bf16* mb; float* stats; const float* rope; const float* qg; const float* kg;
    __device__ __forceinline__ void operator()(const pg8::f32x4 (&acc)[2][2][4][2], const pg8::Unit& u, int wr, int wc, int fr, int fq) const {
        const int pn = u.pn, row0 = u.pm * 256 + wr * 64 + fr;
        if (pn < 18) {
            const int g = pn / 6, t = (pn % 6) >> 1, head = (pn & 1) * 4 + wc, b = u.pm >> 3, dsh = 2 * g;
            bf16* base = qkv + (size_t)((((b * 3 + g) * 3 + t) * 8 + head) * 2048) * 64 + 8 * fq;
            if (t < 2) {
                const float* gp = (t == 0 ? qg : kg) + g * 64 + 8 * fq; const float gs = (t == 0) ? QSCALE : 1.f;
                f32x4 gn[2][2];
#pragma unroll
                for (int bj = 0; bj < 2; ++bj)
#pragma unroll
                    for (int n = 0; n < 2; ++n) gn[bj][n] = *(const f32x4*)(gp + 32 * bj + 4 * n) * gs;
                const float sgn = (fq == 0) ? -1.f : 1.f; const bool dorope = fq < 2;
#pragma unroll
                for (int ai = 0; ai < 2; ++ai)
#pragma unroll
                    for (int m = 0; m < 4; ++m) {
                        const int row = row0 + ai * 128 + m * 16, s = row & 2047, sp = ((s & ((1 << dsh) - 1)) << (11 - dsh)) + (s >> dsh);
                        f32x4 v[2][2]; float ss = 0.f;
#pragma unroll
                        for (int bj = 0; bj < 2; ++bj)
#pragma unroll
                            for (int n = 0; n < 2; ++n) { v[bj][n] = acc[ai][bj][m][n]; const f32x4 q = v[bj][n] * v[bj][n]; ss += (q[0] + q[1]) + (q[2] + q[3]); }
                        ss += __shfl_xor(ss, 16); ss += __shfl_xor(ss, 32);
                        const float rstd = __builtin_amdgcn_rsqf(ss * (1.f / 64.f) + EPSN);
#pragma unroll
                        for (int bj = 0; bj < 2; ++bj)
#pragma unroll
                            for (int n = 0; n < 2; ++n) v[bj][n] = (v[bj][n] * rstd) * gn[bj][n];
                        const f32x4* rp = (const f32x4*)(rope + (size_t)row * 16);
#pragma unroll
                        for (int n = 0; n < 2; ++n) { const f32x4 c = rp[n], sn = rp[2 + n]; f32x4 pr;
#pragma unroll
                            for (int e = 0; e < 4; ++e) pr[e] = __shfl_xor(v[0][n][e], 16);
                            const f32x4 r = v[0][n] * c + (pr * sn) * sgn; if (dorope) v[0][n] = r; }
                        bf16* dst = base + (size_t)sp * 64;
                        *(v4u*)(dst) = pack8(v[0][0], v[0][1]); *(v4u*)(dst + 32) = pack8(v[1][0], v[1][1]);
                        if (m & 1) asm volatile("" ::: "memory");
                    }
            } else {
#pragma unroll
                for (int ai = 0; ai < 2; ++ai)
#pragma unroll
                    for (int m = 0; m < 4; ++m) {
                        const int row = row0 + ai * 128 + m * 16, s = row & 2047, sp = ((s & ((1 << dsh) - 1)) << (11 - dsh)) + (s >> dsh);
                        bf16* dst = base + (size_t)sp * 64;
                        *(v4u*)(dst) = pack8(acc[ai][0][m][0], acc[ai][0][m][1]); *(v4u*)(dst + 32) = pack8(acc[ai][1][m][0], acc[ai][1][m][1]);
                    }
            }
        } else if (pn < 20) {
            bf16* basep = ga + (pn - 18) * 256 + wc * 32 + 8 * fq;
#pragma unroll
            for (int ai = 0; ai < 2; ++ai)
#pragma unroll
                for (int m = 0; m < 4; ++m) { bf16* dst = basep + (size_t)(row0 + ai * 128 + m * 16) * 512;
#pragma unroll
                    for (int bj = 0; bj < 2; ++bj) *(v4u*)(dst + bj * 128) = pack8(silu4(acc[ai][bj][m][0]), silu4(acc[ai][bj][m][1])); }
        } else if (pn < 24) {
            bf16* basep = ug + (pn - 20) * 128 + wc * 32 + 8 * fq;
#pragma unroll
            for (int ai = 0; ai < 2; ++ai)
#pragma unroll
                for (int m = 0; m < 4; ++m) { bf16* dst = basep + (size_t)(row0 + ai * 128 + m * 16) * 512;
                    *(v4u*)(dst) = pack8(gelu4(acc[ai][0][m][0]) * silu4(acc[ai][1][m][0]), gelu4(acc[ai][0][m][1]) * silu4(acc[ai][1][m][1])); }
        } else if (pn < 26) {
            bf16* basep = vg + (pn - 24) * 256 + wc * 32 + 8 * fq;
#pragma unroll
            for (int ai = 0; ai < 2; ++ai)
#pragma unroll
                for (int m = 0; m < 4; ++m) { const int row = row0 + ai * 128 + m * 16; bf16* dst = basep + (size_t)row * 512; float s1 = 0.f, s2 = 0.f;
#pragma unroll
                    for (int bj = 0; bj < 2; ++bj) { const f32x4 a = gelu4(acc[ai][bj][m][0]), c = gelu4(acc[ai][bj][m][1]);
                        s1 += ((a[0] + a[1]) + (a[2] + a[3])) + ((c[0] + c[1]) + (c[2] + c[3]));
                        const f32x4 a2 = a * a, c2 = c * c; s2 += ((a2[0] + a2[1]) + (a2[2] + a2[3])) + ((c2[0] + c2[1]) + (c2[2] + c2[3]));
                        *(v4u*)(dst + bj * 128) = pack8(a, c); }
                    s1 += __shfl_xor(s1, 16); s1 += __shfl_xor(s1, 32); s2 += __shfl_xor(s2, 16); s2 += __shfl_xor(s2, 32);
                    if (fq == 0) *(f32x2*)(stats + ((size_t)row * 8 + (pn - 24) * 4 + wc) * 2) = (f32x2){s1, s2}; }
        } else {
            bf16* basep = (pn < 30 ? ma : mb) + ((pn - 26) & 3) * 256 + wc * 32 + 8 * fq;
#pragma unroll
            for (int ai = 0; ai < 2; ++ai)
#pragma unroll
                for (int m = 0; m < 4; ++m) { bf16* dst = basep + (size_t)(row0 + ai * 128 + m * 16) * 1024;
#pragma unroll
                    for (int bj = 0; bj < 2; ++bj) *(v4u*)(dst + bj * 128) = pack8(sigm4(acc[ai][bj][m][0]), sigm4(acc[ai][bj][m][1])); }
        }
    }
};
struct EpiMrg {
    static constexpr bool PERM = true, AFTER_DRAIN = false;
    const bf16* ma; const bf16* mb; float* tmp; bf16* merged;
    __device__ __forceinline__ void operator()(const pg8::f32x4 (&acc)[2][2][4][2], const pg8::Unit& u, int wr, int wc, int fr, int fq) const {
        const bool second = u.pm >= 64; const int pm = u.pm & 63, pn = u.pn & 3;
        const int row0 = pm * 256 + wr * 64 + fr, col0 = pn * 256 + wc * 32 + 8 * fq;
        const bf16* gsrc = second ? mb : ma;
#pragma unroll
        for (int ai = 0; ai < 2; ++ai)
#pragma unroll
            for (int m = 0; m < 4; ++m) { const size_t ro = (size_t)(row0 + ai * 128 + m * 16) * 1024 + col0;
#pragma unroll
                for (int bj = 0; bj < 2; ++bj) { const size_t off = ro + bj * 128; const v4u gw = *(const v4u*)(gsrc + off);
                    const f32x4 g0 = {bflo(gw.x), bfhi(gw.x), bflo(gw.y), bfhi(gw.y)}, g1 = {bflo(gw.z), bfhi(gw.z), bflo(gw.w), bfhi(gw.w)};
                    f32x4 r0 = g0 * acc[ai][bj][m][0], r1 = g1 * acc[ai][bj][m][1];
                    if (!second) { *(f32x4*)(tmp + off) = r0; *(f32x4*)(tmp + off + 4) = r1; }
                    else { r0 += *(const f32x4*)(tmp + off); r1 += *(const f32x4*)(tmp + off + 4); *(v4u*)(merged + off) = pack8(r0, r1); } }
                if (m & 1) asm volatile("" ::: "memory"); }
    }
};
struct EpiOut {
    static constexpr bool PERM = true, AFTER_DRAIN = false;
    const float* x; const float* ada; float* out; const bf16* dbg_a; const bf16* dbg_b;
    __device__ __forceinline__ void operator()(const pg8::f32x4 (&acc)[2][2][4][2], const pg8::Unit& u, int wr, int wc, int fr, int fq) const {
        const int row0 = u.pm * 256 + wr * 64 + fr, col0 = u.pn * 256 + wc * 32 + 8 * fq, b = u.pm >> 3;
        f32x4 gt[2][2];
#pragma unroll
        for (int bj = 0; bj < 2; ++bj)
#pragma unroll
            for (int n = 0; n < 2; ++n) gt[bj][n] = *(const f32x4*)(ada + b * 3072 + 2048 + col0 + bj * 128 + 4 * n);
#pragma unroll
        for (int ai = 0; ai < 2; ++ai)
#pragma unroll
            for (int m = 0; m < 4; ++m) { const size_t ro = (size_t)(row0 + ai * 128 + m * 16) * 1024 + col0;
#pragma unroll
                for (int bj = 0; bj < 2; ++bj)
#pragma unroll
                    for (int n = 0; n < 2; ++n) { const size_t off = ro + bj * 128 + 4 * n;
#ifdef DBG_PROBE
                        f32x4 pv; for (int e = 0; e < 4; ++e) pv[e] = 0.05f * (bflo(dbg_a[off + e]) + bflo(dbg_b[off + e]));
                        *(f32x4*)(out + off) = *(const f32x4*)(x + off) + pv + 0.f * gt[bj][n] * acc[ai][bj][m][n];
#else
                        *(f32x4*)(out + off) = *(const f32x4*)(x + off) + gt[bj][n] * acc[ai][bj][m][n];
#endif
                    }
                if (m & 1) asm volatile("" ::: "memory"); }
    }
};
struct RevOrder {
    pg8::StaticOrder S; int n;
    __device__ __forceinline__ void init(int M, int N, int G, int c) { S.init(M, N, G, c); n = (S.nwg - c + G - 1) / G; }
    __device__ __forceinline__ bool next(int i, pg8::Unit& u) const { if (i >= n) return false; return S.next(n - 1 - i, u); }
    __device__ __forceinline__ void a_ready(const pg8::Unit&) const {}
    __device__ __forceinline__ void done(const pg8::Unit&) const {}
};
struct PairOrder {
    int G, c;
    __device__ __forceinline__ bool next(int i, pg8::Unit& u) const {
        const int p = (i >> 1) * G + c; if (p >= 256) return false;
        const int x = p & 7, idx = p >> 3; int pm = 8 * x + (idx & 7), pn = idx >> 3;
        if (i & 1) { pm += 64; pn += 4; }
        u.pm = pm; u.pn = pn; return true;
    }
    __device__ __forceinline__ void a_ready(const pg8::Unit&) const {}
    __device__ __forceinline__ void done(const pg8::Unit&) const {}
};

namespace att {
constexpr int KOFF = 0, VOFF = 49152, OSTOFF = 98304, WSOFF = 131072;
__device__ __forceinline__ int crow(int r, int hi) { return (r & 3) + 8 * (r >> 2) + 4 * hi; }
__device__ __forceinline__ v4i16_t vtr(const LAS unsigned char* p) { return __builtin_amdgcn_ds_read_tr16_b64_v4i16((LAS v4i16_t*)p); }
__device__ __forceinline__ void attn_item(int a, bf16* qkv, float* lse, const float* ref2tab, LAS unsigned char* lds) {
    const int tid = threadIdx.x, lane = tid & 63, r32 = lane & 31, hi = lane >> 5, wid = __builtin_amdgcn_readfirstlane(tid >> 6);
    const int p = a & 7, h = (a >> 3) & 7, bg = a >> 6, g = bg % 3, b = bg / 3;
    bf16* Qs = qkv + (size_t)((bg * 3 * 8 + h) * 2048) * 64;
    const bf16* Ks = Qs + (size_t)8 * 2048 * 64; const bf16* Vs = Ks + (size_t)8 * 2048 * 64;
    const int sbase = 256 * p - 128;
    const float ref2 = __hip_atomic_load(ref2tab + g, __ATOMIC_RELAXED, __HIP_MEMORY_SCOPE_AGENT);
    __syncthreads();
#pragma unroll
    for (int tile = 0; tile < 6; ++tile) { const int ks0 = sbase + 64 * tile;
        if (ks0 >= 0) {
            __builtin_amdgcn_global_load_lds((const unsigned*)(Ks + (size_t)(ks0 + lane) * 64 + wid * 8), (LAS unsigned*)(lds + KOFF + tile * 8192 + wid * 1024), 16, 0, 0);
            __builtin_amdgcn_global_load_lds((const unsigned*)(Vs + (size_t)(ks0 + 16 * (wid & 3) + (lane >> 2)) * 64 + (wid >> 2) * 32 + (lane & 3) * 8), (LAS unsigned*)(lds + VOFF + tile * 8192 + wid * 1024), 16, 0, 0);
        } }
    const int qrow = 256 * p + 32 * wid + r32;
    bf16x8 qr[4];
#pragma unroll
    for (int d0 = 0; d0 < 4; ++d0) qr[d0] = *(const bf16x8*)(Qs + (size_t)qrow * 64 + d0 * 16 + hi * 8);
    asm volatile("s_waitcnt vmcnt(0)" ::: "memory"); __syncthreads();
    f32x16 o0, o1;
#pragma unroll
    for (int r = 0; r < 16; ++r) { o0[r] = 0.f; o1[r] = 0.f; }
    float l = 0.f;
    const int Lsh = 11 - 2 * g, nu = 2 * p + (wid >> 2), cs = ((128 * nu) >> Lsh) << Lsh, c = 32 * (wid & 1) + r32;
    const LAS unsigned char* kb = lds + KOFF + hi * 1024 + r32 * 16;
    const LAS unsigned char* vb = lds + VOFF + ((lane >> 4) & 1) * 32 + (lane & 3) * 8 + (4 * hi + ((lane & 15) >> 2)) * 64;
#pragma unroll
    for (int s = 0; s < 3; ++s) {
        const int tile = (wid >> 1) + s;
        if (sbase + 64 * tile >= cs) {
            f32x16 p0, p1;
#pragma unroll
            for (int r = 0; r < 16; ++r) { p0[r] = -ref2; p1[r] = -ref2; }
#pragma unroll
            for (int d0 = 0; d0 < 4; ++d0) { const bf16x8 k0 = *(const LAS bf16x8*)(kb + tile * 8192 + d0 * 2048), k1 = *(const LAS bf16x8*)(kb + tile * 8192 + d0 * 2048 + 512);
                p0 = __builtin_amdgcn_mfma_f32_32x32x16_bf16(k0, qr[d0], p0, 0, 0, 0); p1 = __builtin_amdgcn_mfma_f32_32x32x16_bf16(k1, qr[d0], p1, 0, 0, 0); }
#pragma unroll
            for (int r = 0; r < 16; ++r) { const int kv0 = crow(r, hi), kv1 = kv0 + 32;
                const bool v0 = (s == 0) ? (kv0 >= c) : (s == 2) ? (kv0 <= c) : true, v1 = (s == 0) ? (kv1 >= c) : (s == 2) ? (kv1 <= c) : true;
                const float e0 = v0 ? __builtin_amdgcn_exp2f(p0[r]) : 0.f, e1 = v1 ? __builtin_amdgcn_exp2f(p1[r]) : 0.f;
                p0[r] = e0; p1[r] = e1; l += e0 + e1; }
            v4u pw[4];
            pw[0] = (v4u){pg8::cvt_pk_bf16(p0[0], p0[1]), pg8::cvt_pk_bf16(p0[2], p0[3]), pg8::cvt_pk_bf16(p0[4], p0[5]), pg8::cvt_pk_bf16(p0[6], p0[7])};
            pw[1] = (v4u){pg8::cvt_pk_bf16(p0[8], p0[9]), pg8::cvt_pk_bf16(p0[10], p0[11]), pg8::cvt_pk_bf16(p0[12], p0[13]), pg8::cvt_pk_bf16(p0[14], p0[15])};
            pw[2] = (v4u){pg8::cvt_pk_bf16(p1[0], p1[1]), pg8::cvt_pk_bf16(p1[2], p1[3]), pg8::cvt_pk_bf16(p1[4], p1[5]), pg8::cvt_pk_bf16(p1[6], p1[7])};
            pw[3] = (v4u){pg8::cvt_pk_bf16(p1[8], p1[9]), pg8::cvt_pk_bf16(p1[10], p1[11]), pg8::cvt_pk_bf16(p1[12], p1[13]), pg8::cvt_pk_bf16(p1[14], p1[15])};
#pragma unroll
            for (int ks = 0; ks < 4; ++ks) { const bf16x8 pa = __builtin_bit_cast(bf16x8, pw[ks]);
                { const v4i16_t lo = vtr(vb + tile * 8192 + ks * 1024), hh = vtr(vb + tile * 8192 + ks * 1024 + 512);
                  o0 = __builtin_amdgcn_mfma_f32_32x32x16_bf16(pa, (bf16x8){lo[0], lo[1], lo[2], lo[3], hh[0], hh[1], hh[2], hh[3]}, o0, 0, 0, 0); }
                { const v4i16_t lo = vtr(vb + tile * 8192 + 4096 + ks * 1024), hh = vtr(vb + tile * 8192 + 4096 + ks * 1024 + 512);
                  o1 = __builtin_amdgcn_mfma_f32_32x32x16_bf16(pa, (bf16x8){lo[0], lo[1], lo[2], lo[3], hh[0], hh[1], hh[2], hh[3]}, o1, 0, 0, 0); } }
        }
    }
    l += __shfl_xor(l, 32);
    LAS float* wsf = (LAS float*)(lds + WSOFF) + wid * 64;
    if (hi == 0) wsf[r32] = l;
    asm volatile("s_waitcnt lgkmcnt(0)" ::: "memory");
    LAS bf16* stg = (LAS bf16*)(lds + OSTOFF) + wid * 2048;
#pragma unroll
    for (int r = 0; r < 16; ++r) { const int orow = crow(r, hi); const float rl = __builtin_amdgcn_rcpf(wsf[orow]);
        stg[orow * 64 + r32] = (bf16)f2bf(o0[r] * rl); stg[orow * 64 + 32 + r32] = (bf16)f2bf(o1[r] * rl); }
    asm volatile("s_waitcnt lgkmcnt(0)" ::: "memory");
    bf16* Ow = Qs + (size_t)(256 * p + 32 * wid) * 64;
#pragma unroll
    for (int i = 0; i < 4; ++i) { const int row = i * 8 + (lane >> 3), ch = lane & 7; const v4u v = *(const LAS v4u*)(stg + row * 64 + ch * 8); *(v4u*)(Ow + (size_t)row * 64 + ch * 8) = v; }
    if (hi == 0) lse[((size_t)(g * 8 + b) * 8 + h) * 2048 + qrow] = (__builtin_amdgcn_logf(l) + ref2) * LN2;
}
}

__device__ __forceinline__ void gmlp_item(int idx, const bf16* vg, bf16* ug, const float* stats, const bf16* wsp, const float* bsp, const float* lng, const float* lnb, LAS unsigned char* lds) {
    const int tid = threadIdx.x, lane = tid & 63, r32 = lane & 31, hi = lane >> 5, wid = __builtin_amdgcn_readfirstlane(tid >> 6);
    const int g = idx & 7, nc = (idx >> 3) & 15, b = idx >> 7, tok0 = b * 2048 + nc * 128, c0 = 64 * g;
    const int s = tid >> 2, part = tid & 3; const size_t tok = (size_t)tok0 + s;
    constexpr int SVOFF = 16384, SVP = 65;
    __syncthreads();
    {
        const f32x4* sp = (const f32x4*)(stats + tok * 16); const f32x4 a0 = sp[0], a1 = sp[1], a2 = sp[2], a3 = sp[3];
        const float s1 = ((a0[0] + a0[2]) + (a1[0] + a1[2])) + ((a2[0] + a2[2]) + (a3[0] + a3[2])), s2 = ((a0[1] + a0[3]) + (a1[1] + a1[3])) + ((a2[1] + a2[3]) + (a3[1] + a3[3]));
        const float mean = s1 * (1.f / 512.f), var = fmaxf(s2 * (1.f / 512.f) - mean * mean, 0.f), rstd = __builtin_amdgcn_rsqf(var + EPSN);
        const v4u* vp = (const v4u*)(vg + tok * 512 + c0 + part * 16); const v4u w0 = vp[0], w1 = vp[1];
        const f32x4* gp = (const f32x4*)(lng + c0 + part * 16); const f32x4* bp = (const f32x4*)(lnb + c0 + part * 16);
        f32x4 x0 = {bflo(w0.x), bfhi(w0.x), bflo(w0.y), bfhi(w0.y)}, x1 = {bflo(w0.z), bfhi(w0.z), bflo(w0.w), bfhi(w0.w)};
        f32x4 x2 = {bflo(w1.x), bfhi(w1.x), bflo(w1.y), bfhi(w1.y)}, x3 = {bflo(w1.z), bfhi(w1.z), bflo(w1.w), bfhi(w1.w)};
        x0 = ((x0 - mean) * rstd) * gp[0] + bp[0]; x1 = ((x1 - mean) * rstd) * gp[1] + bp[1]; x2 = ((x2 - mean) * rstd) * gp[2] + bp[2]; x3 = ((x3 - mean) * rstd) * gp[3] + bp[3];
        LAS unsigned char* dst = lds + (s >> 6) * 8192 + (part >> 1) * 4096 + ((s & 63) >> 4) * 1024 + (s & 15) * 64 + (part & 1) * 32;
        *(LAS v4u*)(dst) = pack8(x0, x1); *(LAS v4u*)(dst + 16) = pack8(x2, x3);
    }
    __syncthreads();
    {
        const int tt = wid >> 1, ct = wid & 1;
        f32x16 acc;
#pragma unroll
        for (int r = 0; r < 16; ++r) acc[r] = 0.f;
        const bf16* wrow = wsp + (size_t)(g * 128 + 32 * tt + r32) * 128 + 8 * hi;
        const LAS unsigned char* bb = lds + ct * 4096 + (8 * hi + ((lane & 15) >> 2)) * 64 + ((lane >> 4) & 1) * 32 + (lane & 3) * 8;
#pragma unroll
        for (int ks = 0; ks < 8; ++ks) if (ks < 2 * (tt + 1)) {
            const bf16x8 A = *(const bf16x8*)(wrow + 16 * ks);
            const LAS unsigned char* b2 = bb + (ks >> 2) * 8192 + (ks & 3) * 1024;
            const v4i16_t lo = att::vtr(b2), hh = att::vtr(b2 + 256);
            acc = __builtin_amdgcn_mfma_f32_32x32x16_bf16(A, (bf16x8){lo[0], lo[1], lo[2], lo[3], hh[0], hh[1], hh[2], hh[3]}, acc, 0, 0, 0);
        }
        LAS float* sv = (LAS float*)(lds + SVOFF);
#pragma unroll
        for (int r = 0; r < 16; ++r) sv[(32 * tt + att::crow(r, hi)) * SVP + 32 * ct + r32] = acc[r];
    }
    __syncthreads();
    {
        const LAS float* sv = (const LAS float*)(lds + SVOFF) + s * SVP + part * 16; const float bs = bsp[g * 128 + s];
        bf16* up = ug + tok * 512 + c0 + part * 16; const v4u w0 = *(const v4u*)up, w1 = *(const v4u*)(up + 8);
        f32x4 y0 = {bflo(w0.x) * (sv[0] + bs), bfhi(w0.x) * (sv[1] + bs), bflo(w0.y) * (sv[2] + bs), bfhi(w0.y) * (sv[3] + bs)};
        f32x4 y1 = {bflo(w0.z) * (sv[4] + bs), bfhi(w0.z) * (sv[5] + bs), bflo(w0.w) * (sv[6] + bs), bfhi(w0.w) * (sv[7] + bs)};
        f32x4 y2 = {bflo(w1.x) * (sv[8] + bs), bfhi(w1.x) * (sv[9] + bs), bflo(w1.y) * (sv[10] + bs), bfhi(w1.y) * (sv[11] + bs)};
        f32x4 y3 = {bflo(w1.z) * (sv[12] + bs), bfhi(w1.z) * (sv[13] + bs), bflo(w1.w) * (sv[14] + bs), bfhi(w1.w) * (sv[15] + bs)};
        *(v4u*)up = pack8(y0, y1); *(v4u*)(up + 8) = pack8(y2, y3);
    }
}


__device__ __forceinline__ float wave_sum(float v);
#ifdef DBG_NAIVE_ATT
__device__ __forceinline__ void naive_attn(int gw, int NGW, bf16* qkv, float* lse, LAS unsigned char* lds, int wave, int lane) {
    LAS float* pl = (LAS float*)(lds + wave * 1024);
    for (int it = gw; it < 8 * 3 * 8 * 2048; it += NGW) {
        const int sp = it & 2047, h = (it >> 11) & 7, bg = it >> 14, g = bg % 3;
        bf16* Qs = qkv + (size_t)((bg * 3 * 8 + h) * 2048) * 64; const bf16* Ks = Qs + (size_t)8 * 2048 * 64; const bf16* Vs = Ks + (size_t)8 * 2048 * 64;
        const int L = 2048 >> (2 * g), cls = sp / L, m = sp - cls * L;
        float sc[3]; float mx = -1e30f;
        for (int r = 0; r < 3; ++r) { const int j = r * 64 + lane; const int mk = m - j; float s = -1e30f;
            if (j <= 128 && mk >= 0) { s = 0.f; const bf16* kr = Ks + (size_t)(cls * L + mk) * 64; const bf16* qr = Qs + (size_t)sp * 64;
                for (int d = 0; d < 64; ++d) s += bflo(qr[d]) * bflo(kr[d]); }
            sc[r] = s; mx = fmaxf(mx, s); }
        for (int o = 1; o < 64; o <<= 1) mx = fmaxf(mx, __shfl_xor(mx, o));
        float l = 0.f;
        for (int r = 0; r < 3; ++r) { const float p = (sc[r] > -1e29f) ? exp2f(sc[r] - mx) : 0.f; l += p; pl[r * 64 + lane] = p; }
        l = wave_sum(l);
        asm volatile("s_waitcnt lgkmcnt(0)" ::: "memory");
        float o = 0.f;
        for (int j = 0; j <= 128; ++j) { const int mk = m - j; if (mk < 0) break; o += pl[j] * bflo(Vs[(size_t)(cls * L + mk) * 64 + lane]); }
        asm volatile("s_waitcnt lgkmcnt(0)" ::: "memory");
        Qs[(size_t)sp * 64 + lane] = (bf16)f2bf(o / l);
        if (lane == 0) lse[((size_t)((bg % 3) * 8 + bg / 3) * 8 + h) * 2048 + sp] = (log2f(l) + mx) * LN2;
    }
}
#endif
#ifdef DBG_NAIVE_GMLP
__device__ __forceinline__ void naive_gmlp_stats(int gw, int NGW, const bf16* vg, float* st2, int lane) {
    for (int tok = gw; tok < MTOK; tok += NGW) { float s1 = 0.f, s2 = 0.f;
        for (int j = 0; j < 8; ++j) { const float v = bflo(vg[(size_t)tok * 512 + j * 64 + lane]); s1 += v; s2 += v * v; }
        s1 = wave_sum(s1); s2 = wave_sum(s2); const float mean = s1 / 512.f, var = s2 / 512.f - mean * mean;
        if (lane == 0) { st2[tok * 2] = mean; st2[tok * 2 + 1] = 1.f / sqrtf(var + EPSN); } }
}
__device__ __forceinline__ void naive_gmlp(int gtid, int NGT, const bf16* vg, const bf16* ug, bf16* yb, const float* st2, const float* wsp, const float* bsp, const float* lng, const float* lnb) {
    for (int it = gtid; it < MTOK * 512; it += NGT) { const int tok = it >> 9, c = it & 511, g = c >> 6, t = tok & 127, tok0 = tok - t;
        float acc = 0.f;
        for (int s = 0; s <= t; ++s) { const float vl = (bflo(vg[(size_t)(tok0 + s) * 512 + c]) - st2[(tok0 + s) * 2]) * st2[(tok0 + s) * 2 + 1] * lng[c] + lnb[c];
            acc += wsp[(g * 128 + t) * 128 + s] * bflo((unsigned short)f2bf(vl)); }
        yb[(size_t)tok * 512 + c] = (bf16)f2bf(bflo(ug[(size_t)tok * 512 + c]) * (acc + bsp[g * 128 + t])); }
}
#endif

struct Args { const float* x; const float* c; const int* pos; const float* norm_g; const float* w_ada; const float* b_ada; const float* w_in; const float* qg; const float* kg;
              const float* lng; const float* lnb; const float* wsp; const float* bsp; const float* wa; const float* wb; const float* wout;
              float* out; unsigned char* ws; int ph_lo, ph_hi, li, pad; };

__device__ __forceinline__ float wave_sum(float v) {
#pragma unroll
    for (int o = 1; o < 64; o <<= 1) v += __shfl_xor(v, o);
    return v;
}
__device__ __forceinline__ void transpose_item(const float* W, int K, int N, bf16* WT, int src0, int dst0, int k0, LAS float* scr, int lane) {
#pragma unroll 8
    for (int i = 0; i < 32; ++i) { const int kk = 2 * i + (lane >> 5); scr[kk * 33 + (lane & 31)] = W[(size_t)(k0 + kk) * N + src0 + (lane & 31)]; }
    LDS_WAIT(); asm volatile("" ::: "memory");
    const int c = lane & 7;
#pragma unroll
    for (int j = 0; j < 4; ++j) { const int n = (lane >> 3) + 8 * j; const LAS float* s = scr + (8 * c) * 33 + n;
        v4u o; o.x = pk2(s[0 * 33], s[1 * 33]); o.y = pk2(s[2 * 33], s[3 * 33]); o.z = pk2(s[4 * 33], s[5 * 33]); o.w = pk2(s[6 * 33], s[7 * 33]);
        *(GAS v4u*)(WT + (size_t)(dst0 + n) * K + k0 + 8 * c) = o; }
    LDS_WAIT(); asm volatile("" ::: "memory");
}

__global__ void __launch_bounds__(NWAVES * 64, 2) fwd_kernel(Args args) {
    extern __shared__ __attribute__((aligned(16))) unsigned char lds_raw[];
    LAS unsigned char* lds = (LAS unsigned char*)lds_raw;
    volatile LAS unsigned* MISC = (volatile LAS unsigned*)(lds + MISC_OFF);
    const int tid = threadIdx.x, lane = tid & 63, wave = __builtin_amdgcn_readfirstlane(tid >> 6);
    const int G = gridDim.x; const int bx = blockIdx.x; const int vcu = (G % 8 == 0) ? (bx % 8) * (G / 8) + bx / 8 : bx;
    unsigned char* ws = args.ws;
    gu32* ctl = (gu32*)(ws + WS_CTL);
    float* ada = (float*)(ws + WS_ADA); float* ref2tab = (float*)(ws + WS_MISC); bf16* wspb = (bf16*)(ws + WS_WSP); float* lse = (float*)(ws + WS_LSE);
    float* stats = (float*)(ws + WS_STATS); float* rope = (float*)(ws + WS_ROPE);
    bf16* win_t = (bf16*)(ws + WS_WIN); bf16* wa_t = (bf16*)(ws + WS_WA); bf16* wb_t = (bf16*)(ws + WS_WB); bf16* wout_t = (bf16*)(ws + WS_WOUT);
    bf16* qkv = (bf16*)(ws + WS_QKV); bf16* ga = (bf16*)(ws + WS_GA); bf16* ug = (bf16*)(ws + WS_UG); bf16* vg = (bf16*)(ws + WS_VG); bf16* mb = (bf16*)(ws + WS_MB);
    bf16* merged = (bf16*)(ws + WS_MERGED); float* tmp = (float*)(ws + WS_TMP);
    bf16* hbuf = (bf16*)((unsigned char*)args.out + OUT_H); bf16* ma = (bf16*)((unsigned char*)args.out + OUT_MA);

    for (int u = tid; u < (LDS_BYTES - LDSCTL_OFF) / 4; u += NWAVES * 64) ((LAS unsigned*)(lds + LDSCTL_OFF))[u] = 0u;
    __syncthreads();
    XcdBarrier bar; bar.bar = (unsigned*)(ctl + CW_BAR); bar.x = 0; bar.st = nullptr;
    if (N_LAUNCHES == 1) bar = xcd_barrier_post((unsigned*)(ctl + CW_BAR), MISC + 8);
    const int lo = args.ph_lo, hi = args.ph_hi;
    if (N_LAUNCHES == 1) xcd_barrier(bar);
    else { __builtin_amdgcn_fence(__ATOMIC_RELEASE, "agent"); asm volatile("s_waitcnt vmcnt(0)" ::: "memory"); __builtin_amdgcn_fence(__ATOMIC_ACQUIRE, "agent"); asm volatile("s_waitcnt vmcnt(0)" ::: "memory"); __syncthreads(); }
#ifdef DBG_CHAIN
#define IN(k) (lo <= (k) && (k) < hi && ((k) < 2 || (k) > 5))
#else
#define IN(k) (lo <= (k) && (k) < hi)
#endif
#define SEAM(k) do { if (lo <= (k) && (k) + 1 < hi) xcd_barrier(bar); } while (0)
    const int gw = vcu * NWAVES + wave, NGW = G * NWAVES, gtid = vcu * (NWAVES * 64) + tid, NGT = G * NWAVES * 64;

    if (IN(0)) {
        LAS float* ldsf = (LAS float*)lds;
#ifndef DBG_NAIVE_01
        for (int blk = vcu; blk < 192; blk += G) {
            __syncthreads();
            for (int i = tid; i < 8 * 1024; i += NWAVES * 64) ldsf[i] = siluf(args.c[i]);
            __syncthreads();
            const int col = tid & 15, ksl = tid >> 4, n = 16 * blk + col;
            float a[8];
#pragma unroll
            for (int b = 0; b < 8; ++b) a[b] = 0.f;
            for (int kk = 0; kk < 32; ++kk) { const int k = ksl * 32 + kk; const float w = args.w_ada[(size_t)k * 3072 + n];
#pragma unroll
                for (int b = 0; b < 8; ++b) a[b] += ldsf[b * 1024 + k] * w; }
            LAS float* red = ldsf + 8192;
#pragma unroll
            for (int b = 0; b < 8; ++b) red[(ksl * 8 + b) * 16 + col] = a[b];
            __syncthreads();
            if (tid < 128) { const int b = tid >> 4; float sacc = 0.f;
                for (int k2 = 0; k2 < 32; ++k2) sacc += red[(k2 * 8 + b) * 16 + col];
                ada[b * 3072 + n] = sacc + args.b_ada[n]; }
        }
#endif
        __syncthreads();
        LAS float* scr = (LAS float*)(lds + wave * 16384);
        constexpr int I_IN = 16 * (NIN / 32), I_A = 8 * 32, I_O = 16 * 32, NITEMS = I_IN + 2 * I_A + I_O;
        for (int it = gw; it < NITEMS; it += NGW) {
            int r = it;
            if (r < I_IN) { const int kb = r / (NIN / 32), nb = r % (NIN / 32); transpose_item(args.w_in, 1024, NIN, win_t, win_srccol(32 * nb), 32 * nb, 64 * kb, scr, lane); continue; } r -= I_IN;
            if (r < I_A) { transpose_item(args.wa, 512, 1024, wa_t, 32 * (r % 32), 32 * (r % 32), 64 * (r / 32), scr, lane); continue; } r -= I_A;
            if (r < I_A) { transpose_item(args.wb, 512, 1024, wb_t, 32 * (r % 32), 32 * (r % 32), 64 * (r / 32), scr, lane); continue; } r -= I_A;
            transpose_item(args.wout, 1024, 1024, wout_t, 32 * (r % 32), 32 * (r % 32), 64 * (r / 32), scr, lane);
        }
        for (int i = gtid; i < 8 * 128 * 128 / 8; i += NGT) {
            const int e0 = i * 8, t = (e0 >> 7) & 127, s0 = e0 & 127; const f32x4 w0 = *(const f32x4*)(args.wsp + e0), w1 = *(const f32x4*)(args.wsp + e0 + 4);
            float v[8] = {w0[0], w0[1], w0[2], w0[3], w1[0], w1[1], w1[2], w1[3]};
#pragma unroll
            for (int j = 0; j < 8; ++j) v[j] = (s0 + j <= t) ? v[j] : 0.f;
            v4u o; o.x = pk2(v[0], v[1]); o.y = pk2(v[2], v[3]); o.z = pk2(v[4], v[5]); o.w = pk2(v[6], v[7]);
            *(v4u*)(wspb + e0) = o;
        }
        for (int i = gtid; i < MTOK * 8; i += NGT) {
            const int tok = i >> 3, fi = i & 7; const float freq = exp2f(-(float)fi * (18.931568569324174f / 8.f));
            const float ang = (float)args.pos[tok] * freq;
            const double ad = (double)ang; const double nrev = rint(ad * 0.15915494309189535); const float rr = (float)(ad - nrev * 6.283185307179586);
            rope[tok * 16 + fi] = cosf(rr); rope[tok * 16 + 8 + fi] = sinf(rr);
        }
#ifdef DBG_NAIVE_01
        for (int it = gtid; it < 8 * 3072; it += NGT) { const int b = it / 3072, n = it % 3072; float a = 0.f;
            for (int k = 0; k < 1024; ++k) { const float cv = args.c[b * 1024 + k]; a += (cv / (1.f + expf(-cv))) * args.w_ada[(size_t)k * 3072 + n]; }
            ada[it] = a + args.b_ada[n]; }
#endif
        if (gtid < 3) { float mq = 0.f, mk = 0.f; for (int d = 0; d < 64; ++d) { mq = fmaxf(mq, fabsf(args.qg[gtid * 64 + d])); mk = fmaxf(mk, fabsf(args.kg[gtid * 64 + d])); }
            ref2tab[gtid] = 8.f * mq * mk * LOG2E * 1.03f + 0.25f; }
    }
    SEAM(0);
#ifdef DBG_NAIVE_01
    if (IN(1)) {
        for (int m = gw; m < MTOK; m += NGW) { const int b = m >> 11; float ss = 0.f;
            for (int j = 0; j < 16; ++j) { const float v = args.x[(size_t)m * 1024 + j * 64 + lane]; ss += v * v; }
            ss = wave_sum(ss); const float rstd = 1.f / sqrtf(ss / 1024.f + EPSN);
            for (int j = 0; j < 16; ++j) { const int k = j * 64 + lane; const float v = args.x[(size_t)m * 1024 + k];
                const bf16 hv = (bf16)f2bf(v * rstd * args.norm_g[k] * (1.f + ada[b * 3072 + 1024 + k]) + ada[b * 3072 + k]); hbuf[(size_t)m * 1024 + k] = hv; mb[(size_t)m * 1024 + k] = hv; } }
    }
#else
    if (IN(1)) {
        for (int m = gw; m < MTOK; m += NGW) {
            const int b = m >> 11; const GAS f32x4* xr = (const GAS f32x4*)(args.x + (size_t)m * DM) + lane;
            f32x4 v[4]; float ss = 0.f;
#pragma unroll
            for (int j = 0; j < 4; ++j) { v[j] = xr[64 * j]; ss += (v[j].x * v[j].x + v[j].y * v[j].y) + (v[j].z * v[j].z + v[j].w * v[j].w); }
            const float rstd = __builtin_amdgcn_rsqf(wave_sum(ss) * (1.f / DM) + EPSN);
            GAS unsigned long long* o8 = (GAS unsigned long long*)(hbuf + (size_t)m * DM) + lane;
#pragma unroll
            for (int j = 0; j < 4; ++j) { const int k0 = 256 * j + 4 * lane;
                const f32x4 gv = *(const f32x4*)(args.norm_g + k0), sc = *(const f32x4*)(ada + b * 3072 + 1024 + k0), sh = *(const f32x4*)(ada + b * 3072 + k0);
                const f32x4 hv = ((v[j] * rstd) * gv) * (sc + 1.f) + sh;
                o8[64 * j] = (unsigned long long)pk2(hv.x, hv.y) | ((unsigned long long)pk2(hv.z, hv.w) << 32); }
        }
    }
#endif
    SEAM(1);
    if (IN(2)) {
        pg8::Gemm g{hbuf, win_t, MTOK, NIN, DM}; pg8::StaticOrder S; S.init(MTOK, NIN, G, bx);
        EpiZ E{qkv, ga, ug, vg, ma, mb, stats, rope, args.qg, args.kg};
#ifdef DBG_PLAIN
        { pg8::Gemm g2{hbuf, win_t, MTOK, 4608, DM}; pg8::StaticOrder S2; S2.init(MTOK, 4608, G, bx);
          pg8::EpiBf16<0> E2{qkv, 4608, nullptr, 0, 0, 1.f};
          pg8::gemm_phase<pg8::EpiBf16<0>, pg8::StaticOrder, true, true>(lds, g2, S2, E2); }
#else
        pg8::gemm_phase<EpiZ, pg8::StaticOrder, false, false>(lds, g, S, E);
#ifdef DBG_NAIVE_2
    if (IN(2)) xcd_barrier(bar);
    if (IN(2)) {
        for (long job = gw; job < (long)MTOK * 128; job += NGW) {
            const int tok = (int)(job / 128), grp = (int)(job % 128), b = tok >> 11, s = tok & 2047;
            { const int ty = grp < 72 ? 0 : grp < 80 ? 1 : grp < 88 ? 2 : grp < 96 ? 3 : grp < 112 ? 4 : 5; if (!((DBG_NAIVE_2 >> ty) & 1)) continue; }
            int col, col2 = -1;
            if (grp < 72) col = grp * 64; else if (grp < 80) col = 4608 + (grp - 72) * 64; else if (grp < 88) { col = 5120 + (grp - 80) * 64; col2 = 6144 + (grp - 80) * 64; }
            else if (grp < 96) col = 5632 + (grp - 88) * 64; else col = 6656 + (grp - 96) * 64;
            float z = 0.f, z2 = 0.f;
            for (int k = 0; k < 1024; ++k) { const float hv = bflo(hbuf[(size_t)tok * 1024 + k]); z += hv * args.w_in[(size_t)k * NIN + col + lane]; if (col2 >= 0) z2 += hv * args.w_in[(size_t)k * NIN + col2 + lane]; }
            if (grp < 72) { const int g = grp / 24, t = (grp % 24) / 8, h = grp % 8, dsh = 2 * g, sp = ((s & ((1 << dsh) - 1)) << (11 - dsh)) + (s >> dsh);
                float v = z;
                if (t < 2) { const float ss = wave_sum(z * z); v = z * (1.f / sqrtf(ss / 64.f + EPSN)) * (t == 0 ? args.qg : args.kg)[g * 64 + lane];
                    const float other = __shfl_xor(v, 8); const int fi = lane & 7; const float cs = rope[tok * 16 + fi], sn = rope[tok * 16 + 8 + fi];
                    if (lane < 8) v = v * cs - other * sn; else if (lane < 16) v = v * cs + other * sn;
                    if (t == 0) v *= QSCALE; }
                qkv[((size_t)(((b * 3 + g) * 3 + t) * 8 + h) * 2048 + sp) * 64 + lane] = (bf16)f2bf(v); }
            else if (grp < 80) ga[(size_t)tok * 512 + (grp - 72) * 64 + lane] = (bf16)f2bf(siluf(z));
            else if (grp < 88) { const float ge = 0.5f * z * (1.f + erff(z * 0.70710678f)); ug[(size_t)tok * 512 + (grp - 80) * 64 + lane] = (bf16)f2bf(ge * siluf(z2)); }
            else if (grp < 96) { const float ge = 0.5f * z * (1.f + erff(z * 0.70710678f)); vg[(size_t)tok * 512 + (grp - 88) * 64 + lane] = (bf16)f2bf(ge); }
            else if (grp < 112) ma[(size_t)tok * 1024 + (grp - 96) * 64 + lane] = (bf16)f2bf(sigm(z));
            else mb[(size_t)tok * 1024 + (grp - 112) * 64 + lane] = (bf16)f2bf(sigm(z));
        }
    }
#endif
    }
#endif
    SEAM(2);
    if (IN(3)) {
#ifdef DBG_NAIVE_ATT
        naive_attn(gw, NGW, qkv, lse, lds, wave, lane);
#else
        for (int a = vcu; a < 8 * 3 * 8 * 8; a += G) att::attn_item(a, qkv, lse, ref2tab, lds);
#endif
#ifdef DBG_NAIVE_GMLP
        { float* st2 = (float*)(ws + 250 * MiB); bf16* yb2 = (bf16*)(ws + 251 * MiB);
          naive_gmlp_stats(gw, NGW, vg, st2, lane);
          xcd_barrier(bar);
          naive_gmlp(gtid, NGT, vg, ug, ug, st2, args.wsp, args.bsp, args.lng, args.lnb); (void)yb2; }
#else
        for (int i = vcu; i < 8 * 16 * 8; i += G) gmlp_item(i, vg, ug, stats, wspb, args.bsp, args.lng, args.lnb, lds);
#endif
    }
    SEAM(3);
    if (IN(4)) {
        for (int it = gtid; it < MTOK * 64; it += NGT) {
            const int tok = it >> 6, h = (it >> 3) & 7, j = it & 7, b = tok >> 11, s = tok & 2047;
            float ls[3]; v4u ov[3];
#pragma unroll
            for (int g = 0; g < 3; ++g) { const int dsh = 2 * g, sp = ((s & ((1 << dsh) - 1)) << (11 - dsh)) + (s >> dsh);
                ls[g] = lse[((size_t)(g * 8 + b) * 8 + h) * 2048 + sp];
                ov[g] = *(const v4u*)(qkv + ((size_t)(((b * 3 + g) * 3) * 8 + h) * 2048 + sp) * 64 + j * 8); }
            const float mx = fmaxf(fmaxf(ls[0], ls[1]), ls[2]);
            float w0 = __builtin_amdgcn_exp2f((ls[0] - mx) * LOG2E), w1 = __builtin_amdgcn_exp2f((ls[1] - mx) * LOG2E), w2 = __builtin_amdgcn_exp2f((ls[2] - mx) * LOG2E);
            const float inv = __builtin_amdgcn_rcpf(w0 + w1 + w2); w0 *= inv; w1 *= inv; w2 *= inv;
            bf16* gp = ga + (size_t)tok * 512 + h * 64 + j * 8; const v4u gv = *(const v4u*)gp;
            v4u o;
#define CMB(f) { const float a0 = (w0 * bflo(ov[0].f) + w1 * bflo(ov[1].f)) + w2 * bflo(ov[2].f), a1 = (w0 * bfhi(ov[0].f) + w1 * bfhi(ov[1].f)) + w2 * bfhi(ov[2].f); o.f = pg8::cvt_pk_bf16(a0 * bflo(gv.f), a1 * bfhi(gv.f)); }
            CMB(x) CMB(y) CMB(z) CMB(w)
#undef CMB
            *(v4u*)gp = o;
        }
    }
    SEAM(4);
#ifdef DBG_NAIVE_56
    if (IN(5)) {
        for (int it = gtid; it < MTOK * 1024; it += NGT) { const int m = it >> 10, n = it & 1023; float da = 0.f, db = 0.f;
            for (int k = 0; k < 512; ++k) { da += bflo(ga[(size_t)m * 512 + k]) * args.wa[(size_t)k * 1024 + n]; db += bflo(ug[(size_t)m * 512 + k]) * args.wb[(size_t)k * 1024 + n]; }
            merged[it] = (bf16)f2bf(bflo(ma[it]) * da + bflo(mb[it]) * db); }
    }
#else
    if (IN(5)) {
        pg8::Gemm g{ga, wa_t, 2 * MTOK, 2048, 512}; PairOrder S{G, bx};
        EpiMrg E{ma, mb, tmp, merged};
        pg8::gemm_phase<EpiMrg, PairOrder, false, false>(lds, g, S, E);
    }
#endif
    SEAM(5);
#ifdef DBG_NAIVE_56
    if (IN(6)) {
        for (int it = gtid; it < MTOK * 1024; it += NGT) { const int m = it >> 10, n = it & 1023; float d = 0.f;
            for (int k = 0; k < 1024; ++k) d += bflo(merged[(size_t)m * 1024 + k]) * args.wout[(size_t)k * 1024 + n];
            args.out[it] = args.x[it] + ada[(m >> 11) * 3072 + 2048 + n] * d; }
    }
#else
    if (IN(6)) {
        pg8::Gemm g{merged, wout_t, MTOK, DM, DM}; pg8::StaticOrder S; S.init(MTOK, DM, G, bx);
        EpiOut E{args.x, ada, args.out, mb, mb};
        pg8::gemm_phase<EpiOut, pg8::StaticOrder, false, false>(lds, g, S, E);
    }

#endif
#ifdef DBG_STOP
    if (IN(7)) {
        float* cs = (float*)(ws + 250 * MiB);
        for (int m = gw; m < MTOK; m += NGW) { float s1 = 0.f, s2 = 0.f;
            for (int j = 0; j < 16; ++j) { const unsigned short a = hbuf[(size_t)m * 1024 + j * 64 + lane], b2 = ma[(size_t)m * 1024 + j * 64 + lane]; s1 += bflo(a); s2 += bflo(b2); }
            s1 = wave_sum(s1); s2 = wave_sum(s2); if (lane == 0) { cs[m * 2] = s1; cs[m * 2 + 1] = s2; } }
    }
    if (IN(8)) {
        const float* cs = (const float*)(ws + 250 * MiB); const float* lsef = lse;
        for (int it = gtid; it < MTOK * 1024; it += NGT) { const int tok = it >> 10, c = it & 1023; const size_t q0 = (size_t)tok * 4608;
            float v = 0.f;
#if DBG_SUB == 1
            v = bflo(ga[(size_t)tok * 512 + (c & 511)]) + bflo(mb[(size_t)tok * 1024 + c]) + cs[tok * 2 + 1] * 1e-2f;
#elif DBG_SUB == 2
            v = bflo(qkv[q0 + c]) + bflo(qkv[q0 + 1024 + c]) + bflo(qkv[q0 + 2048 + c]) + bflo(qkv[q0 + 3072 + c]) + ((c < 512) ? bflo(qkv[q0 + 4096 + c]) : 0.f);
#elif DBG_SUB == 3
            v = bflo(ug[(size_t)tok * 512 + (c & 511)]) + bflo(vg[(size_t)tok * 512 + (c & 511)]) + stats[tok * 16 + (c & 15)] * 1e-3f;
#endif
            args.out[it] = v; }
    }
#endif
    asm volatile("s_waitcnt vmcnt(0)" ::: "memory"); __builtin_amdgcn_fence(__ATOMIC_RELEASE, "agent"); asm volatile("s_waitcnt vmcnt(0)" ::: "memory");
#undef IN
#undef SEAM
}

extern "C" void kernel_launch(void* const* d_in, const int* in_sizes, int n_in, void* d_out, int out_size, void* d_ws, size_t ws_size, hipStream_t stream) {
    static int grid = 0;
    if (grid == 0) {
        if (n_in != 16 || in_sizes[0] != MTOK * DM || out_size != MTOK * DM || ws_size < WS_END) { fprintf(stderr, "kernel_launch: unexpected shapes (n_in %d, in0 %d, out %d, ws %zu); nothing launched\n", n_in, n_in > 0 ? in_sizes[0] : -1, out_size, ws_size); grid = -1; return; }
        int dev = 0, cus = 0, per_cu = 0;
        if (hipGetDevice(&dev) != hipSuccess || hipDeviceGetAttribute(&cus, hipDeviceAttributeMultiprocessorCount, dev) != hipSuccess) { fprintf(stderr, "kernel_launch: device query failed\n"); grid = -1; return; }
        if (hipFuncSetAttribute((const void*)fwd_kernel, hipFuncAttributeMaxDynamicSharedMemorySize, LDS_BYTES) != hipSuccess) { fprintf(stderr, "kernel_launch: hipFuncSetAttribute failed\n"); grid = -1; return; }
        if (hipOccupancyMaxActiveBlocksPerMultiprocessor(&per_cu, (const void*)fwd_kernel, NWAVES * 64, LDS_BYTES) != hipSuccess || per_cu < 1) { fprintf(stderr, "kernel_launch: occupancy query says %d workgroups per CU\n", per_cu); per_cu = 1; }
        (void)hipGetLastError();
        grid = cus;
    }
    if (grid < 0) return;
    if (hipMemsetAsync((char*)d_ws + WS_CTL, 0, CTL_ZERO_BYTES, stream) != hipSuccess) { fprintf(stderr, "kernel_launch: memset failed\n"); return; }
    Args a{};
    a.x = (const float*)d_in[0]; a.c = (const float*)d_in[1]; a.pos = (const int*)d_in[2]; a.norm_g = (const float*)d_in[3]; a.w_ada = (const float*)d_in[4]; a.b_ada = (const float*)d_in[5];
    a.w_in = (const float*)d_in[6]; a.qg = (const float*)d_in[7]; a.kg = (const float*)d_in[8]; a.lng = (const float*)d_in[9]; a.lnb = (const float*)d_in[10]; a.wsp = (const float*)d_in[11];
    a.bsp = (const float*)d_in[12]; a.wa = (const float*)d_in[13]; a.wb = (const float*)d_in[14]; a.wout = (const float*)d_in[15];
    a.out = (float*)d_out; a.ws = (unsigned char*)d_ws;
#ifdef DBG_STOP
    const int nl = DBG_STOP + 3;
#else
    const int nl = N_LAUNCHES;
#endif
    for (int li = 0; li < nl; ++li) {
        a.ph_lo = (N_LAUNCHES == 1) ? 0 : li; a.ph_hi = (N_LAUNCHES == 1) ? N_PHASES : li + 1; a.li = li;
#ifdef DBG_STOP
        if (li > DBG_STOP) { a.ph_lo = 7 + (li - DBG_STOP - 1); a.ph_hi = a.ph_lo + 1; }
#endif
        hipLaunchKernelGGL(fwd_kernel, dim3(grid), dim3(NWAVES * 64), LDS_BYTES, stream, a);
        const hipError_t le = hipPeekAtLastError();
        if (le != hipSuccess) { fprintf(stderr, "kernel_launch: launch %d failed: %s\n", li, hipGetErrorName(le)); break; }
    }
}
```

```cpp
#include <hip/hip_runtime.h>
#include <cstdio>
#include <cstdint>
#include <cmath>
namespace pg8 {
#define PG8_LAS __attribute__((address_space(3)))
typedef unsigned short bf16_t;
typedef short bf16x8 __attribute__((ext_vector_type(8)));
typedef float f32x4 __attribute__((ext_vector_type(4)));
typedef unsigned u32x4 __attribute__((ext_vector_type(4)));
constexpr int BM = 256, BK = 64, HALF = 128, HTB = HALF * BK * 2  , STAGE_BYTES = 8 * HTB, NXCD = 8, WGM = 8;

__host__ __device__ __forceinline__ int lds_byte(int r, int c) { const int st = (r >> 4) * 2 + (c >> 5), rr = r & 15, cc = c & 31, ob = rr * 64 + cc * 2; return st * 1024 + (ob ^ (((ob >> 9) & 1) << 5)); }
__host__ __device__ __forceinline__ void stage_rc(int b, int& R, int& C) { const int st = b / 1024, sb = b % 1024, swz = sb ^ (((sb >> 9) & 1) << 5); R = (st >> 1) * 16 + swz / 64; C = (st & 1) * 32 + (swz % 64) / 2; }
__host__ __device__ __forceinline__ int perm32(int rho) { const int n = rho >> 4, i = rho & 15; return 8 * (i >> 2) + 4 * n + (i & 3); }

struct Unit { int pm, pn; };
struct Gemm { const bf16_t* A; const bf16_t* Bt; int M, N, K; size_t abskip = 0; };

struct StaticOrder {
    int nM, nN, nwg, G, c;
    __host__ __device__ void init(int M, int N, int G_, int c_) { nM = M / BM; nN = N / BM; nwg = nM * nN; G = G_; c = c_; }
    __host__ __device__ bool next(int i, Unit& u) const {
        const long L = (long)i * G + c; if (L >= nwg) return false;
        int wgid = (int)L; { const int q = nwg / NXCD, r = nwg % NXCD, xcd = wgid % NXCD, off = wgid / NXCD; wgid = (xcd < r ? xcd * (q + 1) : r * (q + 1) + (xcd - r) * q) + off; }
        const int nig = WGM * nN, gid = wgid / nig, fm = gid * WGM, gsz = (nM - fm) < WGM ? (nM - fm) : WGM;
        u.pm = fm + ((wgid % nig) % gsz); u.pn = (wgid % nig) / gsz; return true;
    }
    __device__ __forceinline__ void a_ready(const Unit&) const {}
    __device__ __forceinline__ void done(const Unit&) const {}
};

typedef float cvt_f32x2_t __attribute__((ext_vector_type(2))); typedef __bf16 cvt_bf16x2_t __attribute__((ext_vector_type(2)));
__device__ __forceinline__ unsigned cvt_pk_bf16(float lo, float hi) { const cvt_f32x2_t v = {lo, hi}; const cvt_bf16x2_t b = __builtin_convertvector(v, cvt_bf16x2_t); return __builtin_bit_cast(unsigned, b); }
typedef float f32x2 __attribute__((ext_vector_type(2)));
__device__ __forceinline__ f32x2 gelu_pk(f32x2 v) {
    const f32x2 av = __builtin_elementwise_abs(v), d = av * 0.2316418882f + 1.0f;
    f32x2 t; t.x = __builtin_amdgcn_rcpf(d.x); t.y = __builtin_amdgcn_rcpf(d.y);
    f32x2 q = t * 0.5307027145f + (-0.7265760135f); q = q * t + 0.7107068705f; q = q * t + (-0.142248368f); q = q * t + 0.127414796f; q = q * t;
    const f32x2 s = (v * v) * (-0.72134752044f);
    f32x2 e; e.x = __builtin_amdgcn_exp2f(s.x); e.y = __builtin_amdgcn_exp2f(s.y);
    const f32x2 m = v * (q * e), r = v - m;
    f32x2 o; o.x = v.x < 0.f ? m.x : r.x; o.y = v.y < 0.f ? m.y : r.y; return o;
}
template <int ACT  > struct EpiBf16 {
    static constexpr bool PERM = true, AFTER_DRAIN = false, CARRY = false; static_assert(ACT == 0 || ACT == 1, "EpiBf16: ACT is 0 (none) or 1 (gelu_pk)");
    bf16_t* O; int ldc; const float* bias; int split_cols; size_t split_stride; float scale0;
    __device__ __forceinline__ void operator()(const f32x4 (&acc)[2][2][4][2], const Unit& u, int wr, int wc, int fr, int fq) const {
        const int row0 = u.pm * BM + wr * 64 + fr; int colt = u.pn * BM; bf16_t* base = O;
        float sc = 1.f; if (split_cols) { const int t = colt / split_cols; base += (size_t)t * split_stride; colt -= t * split_cols; if (t == 0) sc = scale0; }
        const int col0 = colt + wc * 32 + 8 * fq, bcol0 = u.pn * BM + wc * 32 + 8 * fq;
        f32x4 bv[2][2];
#pragma unroll
        for (int bj = 0; bj < 2; ++bj)
#pragma unroll
            for (int n = 0; n < 2; ++n) bv[bj][n] = bias ? *(const f32x4*)(bias + bcol0 + bj * HALF + 4 * n) : (f32x4){0.f, 0.f, 0.f, 0.f};
#pragma unroll
        for (int ai = 0; ai < 2; ++ai)
#pragma unroll
            for (int m = 0; m < 4; ++m) { bf16_t* rowp = base + (size_t)(row0 + ai * HALF + m * 16) * ldc + col0;
#pragma unroll
                for (int bj = 0; bj < 2; ++bj) { f32x4 v0 = acc[ai][bj][m][0] + bv[bj][0], v1 = acc[ai][bj][m][1] + bv[bj][1];
                    if (ACT == 1) { f32x2 a = gelu_pk((f32x2){v0[0], v0[1]}), b = gelu_pk((f32x2){v0[2], v0[3]}), c = gelu_pk((f32x2){v1[0], v1[1]}), d = gelu_pk((f32x2){v1[2], v1[3]});
                        v0 = (f32x4){a.x, a.y, b.x, b.y}; v1 = (f32x4){c.x, c.y, d.x, d.y}; }
                    v0 = v0 * sc; v1 = v1 * sc; u32x4 w; w.x = cvt_pk_bf16(v0[0], v0[1]); w.y = cvt_pk_bf16(v0[2], v0[3]); w.z = cvt_pk_bf16(v1[0], v1[1]); w.w = cvt_pk_bf16(v1[2], v1[3]);
                    *(u32x4*)(rowp + bj * HALF) = w; } }
    }
};

template <class Epi, class Sched, bool ALIGN_EPI = false, bool SP2 = false>
__device__ __forceinline__ void gemm_phase(PG8_LAS unsigned char* lds, const Gemm g, const Sched& S, const Epi& E) {
    const int tid = threadIdx.x, wid = __builtin_amdgcn_readfirstlane(tid >> 6), lane = tid & 63, wr = wid >> 2, wc = wid & 3, fr = lane & 15, fq = lane >> 4;
    const int K = g.K, nt = K / BK;
    unsigned voffA[2], voffB[2];
#pragma unroll
    for (int i = 0; i < 2; ++i) { int R, C; stage_rc(tid * 16 + i * 8192, R, C); const int Rb = Epi::PERM ? ((R & ~31) + perm32(R & 31)) : R;
        voffA[i] = (unsigned)(R * K + C) * 2u; voffB[i] = (unsigned)(Rb * K + C) * 2u; }
    const size_t kstep = (size_t)(BK * 2);
    const size_t hstep = (size_t)HALF * K * 2;
    const size_t tstep = 2 * hstep;
    const unsigned ldsw = (unsigned)wid * 1024u;
    const int aoff = lds_byte(wr * 64 + fr, fq * 8), boff = lds_byte(wc * 32 + fr, fq * 8);
#define PG8_SA(b, h) (((b) * 2 + (h)) * HTB)
#define PG8_SB(b, h) ((4 + (b) * 2 + (h)) * HTB)
#define PG8_STAGE(bufoff, gbase, voff) do { _Pragma("unroll") for (int _i = 0; _i < 2; ++_i) \
        __builtin_amdgcn_global_load_lds((const unsigned*)((const char*)(gbase) + (voff)[_i]), (PG8_LAS unsigned*)(lds + (bufoff) + ldsw + _i * 8192), 16, 0, 0); } while (0)
#define PG8_LDA(dst, b, h) do { _Pragma("unroll") for (int m = 0; m < 4; ++m) _Pragma("unroll") for (int k = 0; k < 2; ++k) dst[m][k] = *(const PG8_LAS bf16x8*)(lds + PG8_SA(b, h) + aoff + m * 2048 + k * 1024); } while (0)
#define PG8_LDB(dst, b, h) do { _Pragma("unroll") for (int n = 0; n < 2; ++n) _Pragma("unroll") for (int k = 0; k < 2; ++k) dst[n][k] = *(const PG8_LAS bf16x8*)(lds + PG8_SB(b, h) + boff + n * 2048 + k * 1024); } while (0)
#define PG8_MMA(ai, bj, At, Bt) do { __builtin_amdgcn_s_setprio(1); _Pragma("unroll") for (int m = 0; m < 4; ++m) _Pragma("unroll") for (int n = 0; n < 2; ++n) _Pragma("unroll") for (int k = 0; k < 2; ++k) \
        acc[ai][bj][m][n] = __builtin_amdgcn_mfma_f32_16x16x32_bf16(Bt[n][k], At[m][k], acc[ai][bj][m][n], 0, 0, 0); __builtin_amdgcn_s_setprio(0); } while (0)
#define PG8_WAIT_V(n) asm volatile("s_waitcnt vmcnt(" #n ")" ::: "memory")
#define PG8_WAIT_L(n) asm volatile("s_waitcnt lgkmcnt(" #n ")" ::: "memory")
#define PG8_BAR __builtin_amdgcn_s_barrier()
#define PG8_SCHED __builtin_amdgcn_sched_barrier(0)
    Unit cur, nxt; int ui = 0;
    if (!S.next(0, cur)) return;
    f32x4 acc[2][2][4][2];
#pragma unroll
    for (int a = 0; a < 2; ++a)
#pragma unroll
        for (int b = 0; b < 2; ++b)
#pragma unroll
            for (int m = 0; m < 4; ++m)
#pragma unroll
                for (int n = 0; n < 2; ++n) acc[a][b][m][n] = (f32x4){0.f, 0.f, 0.f, 0.f};
    bf16x8 At[4][2], B0[2][2], B1[2][2];
    const char* cA = (const char*)g.A + (size_t)cur.pm * tstep + (size_t)(cur.pm >> 3) * g.abskip; const char* cB = (const char*)g.Bt + (size_t)cur.pn * tstep;
    S.a_ready(cur);
    if constexpr (SP2) {
        PG8_STAGE(PG8_SB(0, 0), cB, voffB); PG8_STAGE(PG8_SB(0, 1), cB + hstep, voffB); PG8_STAGE(PG8_SA(0, 0), cA, voffA); PG8_STAGE(PG8_SA(0, 1), cA + hstep, voffA);
        if (wr == 1) PG8_BAR;
        PG8_WAIT_V(2); PG8_BAR;
        PG8_STAGE(PG8_SB(1, 0), cB + kstep, voffB); PG8_STAGE(PG8_SA(1, 0), cA + kstep, voffA); PG8_STAGE(PG8_SB(1, 1), cB + hstep + kstep, voffB);
        PG8_WAIT_V(6); PG8_BAR;
    } else {
        PG8_STAGE(PG8_SB(0, 0), cB, voffB); PG8_STAGE(PG8_SA(0, 0), cA, voffA); PG8_STAGE(PG8_SB(0, 1), cB + hstep, voffB); PG8_STAGE(PG8_SA(0, 1), cA + hstep, voffA);
        if (wr == 1) PG8_BAR;
        PG8_WAIT_V(4); PG8_BAR;
        PG8_STAGE(PG8_SB(1, 0), cB + kstep, voffB); PG8_STAGE(PG8_SA(1, 0), cA + kstep, voffA); PG8_STAGE(PG8_SB(1, 1), cB + hstep + kstep, voffB);
        PG8_WAIT_V(6); PG8_BAR;
    }
    for (;;) {
        const bool has_next = S.next(ui + 1, nxt);
        const char* nA = has_next ? (const char*)g.A + (size_t)nxt.pm * tstep + (size_t)(nxt.pm >> 3) * g.abskip : cA; const char* nB = has_next ? (const char*)g.Bt + (size_t)nxt.pn * tstep : cB;
        for (int t = 0; t < nt; t += 2) {
            const bool last = (t == nt - 2);
            const char* a1 = cA + (size_t)(t + 1) * kstep;
            const char* a2 = last ? nA : cA + (size_t)(t + 2) * kstep; const char* b2 = last ? nB : cB + (size_t)(t + 2) * kstep;
            const char* a3 = a2 + kstep; const char* b3 = b2 + kstep;
            if (last && has_next) S.a_ready(nxt);
            if constexpr (SP2) {
            PG8_LDB(B0, 0, 0); PG8_LDB(B1, 0, 1); PG8_SCHED; PG8_LDA(At, 0, 0); PG8_STAGE(PG8_SA(1, 1), a1 + hstep, voffA);
            PG8_WAIT_V(8); PG8_WAIT_L(0); PG8_BAR; PG8_MMA(0, 0, At, B0); PG8_MMA(0, 1, At, B1); PG8_BAR; PG8_SCHED;
            PG8_LDA(At, 0, 1); PG8_STAGE(PG8_SB(0, 0), b2, voffB); PG8_STAGE(PG8_SB(0, 1), b2 + hstep, voffB); PG8_STAGE(PG8_SA(0, 0), a2, voffA);
            PG8_WAIT_V(8); PG8_WAIT_L(0); PG8_BAR; PG8_MMA(1, 0, At, B0); PG8_MMA(1, 1, At, B1); PG8_BAR; PG8_SCHED;
            PG8_LDB(B0, 1, 0); PG8_LDB(B1, 1, 1); PG8_SCHED; PG8_LDA(At, 1, 0); PG8_STAGE(PG8_SA(0, 1), a2 + hstep, voffA);
            PG8_WAIT_V(8); PG8_WAIT_L(0); PG8_BAR; PG8_MMA(0, 0, At, B0); PG8_MMA(0, 1, At, B1); PG8_BAR; PG8_SCHED;
            PG8_LDA(At, 1, 1); PG8_STAGE(PG8_SB(1, 0), b3, voffB); PG8_STAGE(PG8_SB(1, 1), b3 + hstep, voffB); PG8_STAGE(PG8_SA(1, 0), a3, voffA);
            PG8_WAIT_V(8); PG8_WAIT_L(0); PG8_BAR; PG8_MMA(1, 0, At, B0); PG8_MMA(1, 1, At, B1); PG8_BAR; PG8_SCHED;
            } else {
            PG8_LDB(B0, 0, 0); PG8_SCHED; PG8_LDA(At, 0, 0); PG8_STAGE(PG8_SA(1, 1), a1 + hstep, voffA);
            PG8_WAIT_L(8); PG8_BAR; PG8_WAIT_L(0); PG8_MMA(0, 0, At, B0); PG8_BAR; PG8_SCHED;
            PG8_LDB(B1, 0, 1); PG8_STAGE(PG8_SB(0, 0), b2, voffB);
            PG8_BAR; PG8_WAIT_L(0); PG8_MMA(0, 1, At, B1); PG8_BAR;
            PG8_LDA(At, 0, 1); PG8_STAGE(PG8_SA(0, 0), a2, voffA);
            PG8_BAR; PG8_WAIT_L(0); PG8_MMA(1, 0, At, B0); PG8_BAR; PG8_SCHED;
            PG8_STAGE(PG8_SB(0, 1), b2 + hstep, voffB);
            PG8_WAIT_V(6); PG8_BAR; PG8_MMA(1, 1, At, B1); PG8_BAR;
            PG8_LDB(B0, 1, 0); PG8_SCHED; PG8_LDA(At, 1, 0); PG8_STAGE(PG8_SA(0, 1), a2 + hstep, voffA);
            PG8_WAIT_L(8); PG8_BAR; PG8_WAIT_L(0); PG8_MMA(0, 0, At, B0); PG8_BAR; PG8_SCHED;
            PG8_LDB(B1, 1, 1); PG8_STAGE(PG8_SB(1, 0), b3, voffB);
            PG8_BAR; PG8_WAIT_L(0); PG8_MMA(0, 1, At, B1); PG8_BAR;
            PG8_LDA(At, 1, 1); PG8_STAGE(PG8_SA(1, 0), a3, voffA);
            PG8_BAR; PG8_WAIT_L(0); PG8_MMA(1, 0, At, B0); PG8_BAR; PG8_SCHED;
            PG8_STAGE(PG8_SB(1, 1), b3 + hstep, voffB);
            PG8_WAIT_V(6); PG8_BAR; PG8_MMA(1, 1, At, B1); PG8_BAR;
            }
        }
        if constexpr (ALIGN_EPI) { if (wr == 0) PG8_BAR; }
        if constexpr (!Epi::AFTER_DRAIN) { E(acc, cur, wr, wc, fr, fq); S.done(cur); }
        if (!has_next) break;
        bool carry_ = false; if constexpr (Epi::CARRY) carry_ = E.carry(cur);
        if (!carry_) {
#pragma unroll
        for (int a = 0; a < 2; ++a)
#pragma unroll
            for (int b = 0; b < 2; ++b)
#pragma unroll
                for (int m = 0; m < 4; ++m)
#pragma unroll
                    for (int n = 0; n < 2; ++n) acc[a][b][m][n] = (f32x4){0.f, 0.f, 0.f, 0.f};
        }
        cur = nxt; cA = nA; cB = nB; ++ui;
        if constexpr (ALIGN_EPI) { if (wr == 1) PG8_BAR; }
    }
    PG8_WAIT_V(0);
    if constexpr (!ALIGN_EPI) { if (wr == 0) PG8_BAR; }
    PG8_BAR;
    if constexpr (Epi::AFTER_DRAIN) { E.fused(acc, cur, wr, wc, fr, fq, lds, wid, lane); S.done(cur); }
#undef PG8_SA
#undef PG8_SB
#undef PG8_STAGE
#undef PG8_LDA
#undef PG8_LDB
#undef PG8_MMA
#undef PG8_WAIT_V
#undef PG8_WAIT_L
#undef PG8_BAR
#undef PG8_SCHED
}
}
#define GAS __attribute__((address_space(1)))
#define LAS __attribute__((address_space(3)))
typedef unsigned short bf16;
typedef unsigned v4u __attribute__((ext_vector_type(4)));
typedef float f32x4 __attribute__((ext_vector_type(4)));
typedef short bf16x8 __attribute__((ext_vector_type(8)));
typedef GAS unsigned gu32;
typedef GAS unsigned long long gu64;
#define RLX_AGENT __ATOMIC_RELAXED, __HIP_MEMORY_SCOPE_AGENT
#define LDS_WAIT() asm volatile("s_waitcnt lgkmcnt(0)" ::: "memory")
#define VM_WAIT() asm volatile("s_waitcnt vmcnt(0)" ::: "memory")
__device__ __forceinline__ unsigned long long rt() { return __builtin_amdgcn_s_memrealtime(); }
__device__ __forceinline__ unsigned f2bf(float f) { unsigned u = __builtin_bit_cast(unsigned, f); return (u + 0x7fffu + ((u >> 16) & 1u)) >> 16; }
__device__ __forceinline__ unsigned pk2(float lo, float hi) { return f2bf(lo) | (f2bf(hi) << 16); }
#define XB_TMO      128
#define XB_XCNT(j)  (256  + 64 * (j))
#define XB_XSUB(j)  (1280 + 64 * (j))
#define XB_XGEN(j)  (2304 + 64 * (j))
#define XB_TOP      3328
#define XB_TOPGEN   3392
#define XCD_BAR_WORDS 3456
#define XB_SPIN_CAP (1u << 18)

__device__ __forceinline__ unsigned xb_ld(unsigned* p)              { return __hip_atomic_load(p, __ATOMIC_RELAXED, __HIP_MEMORY_SCOPE_AGENT); }
__device__ __forceinline__ unsigned xb_add(unsigned* p, unsigned v) { return __hip_atomic_fetch_add(p, v, __ATOMIC_RELAXED, __HIP_MEMORY_SCOPE_AGENT); }
__device__ __forceinline__ unsigned xb_xcc_id() { return (unsigned)__builtin_amdgcn_s_getreg((3 << 11) | 20) & 0xFu; }
#define XB_SPIN(cond, bar) do { unsigned _sp = 0; while (cond) { __builtin_amdgcn_s_sleep(1); \
    if ((++_sp & 255u) == 0u) { if (xb_ld(&(bar)[XB_TMO])) break; if (_sp > XB_SPIN_CAP) { atomicAdd(&(bar)[XB_TMO], 1u); break; } } } } while (0)

struct XcdBarrier {
    unsigned* bar; unsigned x;
    volatile LAS unsigned* st;
};

__device__ __forceinline__ XcdBarrier xcd_barrier_post(unsigned* bar, volatile LAS unsigned* st) {
    XcdBarrier b; b.bar = bar; b.x = xb_xcc_id(); b.st = st;
    if (threadIdx.x == 0) (void)xb_add(&bar[XB_XCNT(b.x)], 1u);
    return b;
}
__device__ __forceinline__ void xcd_barrier_complete(unsigned* bar, unsigned x, unsigned& nloc, unsigned& nx) {
    const unsigned G = gridDim.x * gridDim.y * gridDim.z;
    unsigned sum, cnt, mine, sp = 0u;
    for (;;) {
        sum = 0u; cnt = 0u; mine = 0u;
#pragma unroll
        for (unsigned j = 0; j < 16; ++j) { const unsigned c = xb_ld(&bar[XB_XCNT(j)]); sum += c; cnt += (c > 0u) ? 1u : 0u; mine = (j == x) ? c : mine; }
        if (sum == G) break;
        __builtin_amdgcn_s_sleep(1);
        if ((++sp & 255u) == 0u) { if (xb_ld(&bar[XB_TMO])) break; if (sp > XB_SPIN_CAP) { atomicAdd(&bar[XB_TMO], 1u); break; } }
    }
    nloc = mine > 0u ? mine : 1u; nx = cnt > 0u ? cnt : 1u;
}

__device__ __forceinline__ void xcd_barrier(const XcdBarrier& b) {
    asm volatile("s_waitcnt vmcnt(0)" ::: "memory");
    __syncthreads();
    if (threadIdx.x == 0) {
        unsigned* bar = b.bar;
        __builtin_amdgcn_s_waitcnt(0);
        unsigned nloc = b.st[0], nx = b.st[1];
        if (nloc == 0u) { xcd_barrier_complete(bar, b.x, nloc, nx); b.st[0] = nloc; b.st[1] = nx; }
        const unsigned old = xb_add(&bar[XB_XSUB(b.x)], 1u);
        const unsigned gen = old / nloc;
        if (old + 1u == (gen + 1u) * nloc) {
            __builtin_amdgcn_fence(__ATOMIC_RELEASE, "agent");
            asm volatile("s_waitcnt vmcnt(0)" ::: "memory");
            const unsigned og = xb_add(&bar[XB_TOP], 1u);
            const unsigned tg = og / nx;
            if (og + 1u == (tg + 1u) * nx) xb_add(&bar[XB_TOPGEN], 1u);
            else XB_SPIN(xb_ld(&bar[XB_TOPGEN]) == tg, bar);
            __builtin_amdgcn_fence(__ATOMIC_ACQUIRE, "agent");
            xb_add(&bar[XB_XGEN(b.x)], 1u);
            asm volatile("s_waitcnt vmcnt(0)" ::: "memory");
        } else {
            XB_SPIN(xb_ld(&bar[XB_XGEN(b.x)]) == gen, bar);
            __builtin_amdgcn_fence(__ATOMIC_ACQUIRE, "agent");
            asm volatile("s_waitcnt vmcnt(0)" ::: "memory");
        }
    }
    __syncthreads();
}

__device__ __forceinline__ void xcd_barrier_local(const XcdBarrier& b) {
    asm volatile("s_waitcnt vmcnt(0)" ::: "memory");
    __syncthreads();
    if (threadIdx.x == 0) {
        unsigned* bar = b.bar;
        __builtin_amdgcn_s_waitcnt(0);
        unsigned nloc = b.st[0]; if (nloc == 0u) nloc = 1u;
        asm volatile("buffer_inv sc1" ::: "memory");
        const unsigned old = xb_add(&bar[XB_XSUB(b.x)], 1u);
        const unsigned gen = old / nloc;
        if (old + 1u == (gen + 1u) * nloc) xb_add(&bar[XB_XGEN(b.x)], 1u);
        else XB_SPIN(xb_ld(&bar[XB_XGEN(b.x)]) == gen, bar);
        asm volatile("s_waitcnt vmcnt(0)" ::: "memory");
    }
    __syncthreads();
}

__device__ __forceinline__ void xcd_local_arrive(const XcdBarrier& b) {
    unsigned* bar = b.bar; unsigned nloc = b.st[0]; if (nloc == 0u) nloc = 1u;
    const unsigned old = xb_add(&bar[XB_XSUB(b.x)], 1u);
    const unsigned gen = old / nloc;
    if (old + 1u == (gen + 1u) * nloc) xb_add(&bar[XB_XGEN(b.x)], 1u);
    b.st[3] = gen + 1u;
}
__device__ __forceinline__ void xcd_local_wait(const XcdBarrier& b) {
    asm volatile("s_waitcnt vmcnt(0)" ::: "memory");
    __syncthreads();
    if (threadIdx.x == 0) {
        unsigned* bar = b.bar;
        __builtin_amdgcn_s_waitcnt(0);
        const unsigned gen = b.st[3] - 1u; b.st[3] = 0u;
        XB_SPIN(xb_ld(&bar[XB_XGEN(b.x)]) == gen, bar);
        __builtin_amdgcn_fence(__ATOMIC_ACQUIRE, "agent");
        asm volatile("s_waitcnt vmcnt(0)" ::: "memory");
    }
    __syncthreads();
}

constexpr int NWAVES = 8;
#define MK_N_LAUNCHES 1
#ifndef MK_N_LAUNCHES
#define MK_N_LAUNCHES 1
#endif
constexpr int N_PHASES = 7;
constexpr int NZ2 = 26 * 256;
constexpr int N_LAUNCHES = MK_N_LAUNCHES;
constexpr int BATCH = 8, SEQ = 2048, DM = 1024, MTOK = BATCH * SEQ, NIN = 8704;
constexpr float EPSN = 1e-6f, LOG2E = 1.4426950408889634f, LN2 = 0.6931471805599453f, QSCALE = 0.125f * 1.4426950408889634f;
constexpr size_t MiB = 1u << 20;
constexpr size_t WS_CTL = 0, CTL_ZERO_BYTES = 64 * 1024;
constexpr size_t WS_ADA = 1 * MiB;
constexpr size_t WS_MISC = 1 * MiB + 128 * 1024;
constexpr size_t WS_WSP = 1 * MiB + 256 * 1024;
constexpr size_t WS_LSE = 1 * MiB + 512 * 1024;
constexpr size_t WS_STATS = 3 * MiB;
constexpr size_t WS_ROPE = 4 * MiB;
constexpr size_t WS_WIN = 5 * MiB;
constexpr size_t WS_WA = 22 * MiB, WS_WB = 23 * MiB;
constexpr size_t WS_WOUT = 24 * MiB;
constexpr size_t WS_QKV = 26 * MiB;
constexpr size_t WS_GA = 170 * MiB;
constexpr size_t WS_UG = 186 * MiB;
constexpr size_t WS_VG = 202 * MiB;
constexpr size_t OVL_BSTR = 18 * MiB / 2;
constexpr size_t WS_MERGED = 26 * MiB;
constexpr size_t WS_MA = 26 * MiB + 4 * MiB;
constexpr size_t WS_MBO = 26 * MiB + 8 * MiB;
constexpr size_t WS_H = 218 * MiB;
__host__ __device__ __forceinline__ size_t ovl_row(int r) { return (size_t)(r >> 11) * OVL_BSTR + (size_t)(r & 2047) * 1024; }
constexpr size_t WS_END = 250 * MiB;
constexpr int CW_BAR = 4096, CW_GRP = 8192;
constexpr int LDSCTL_OFF = 149504, MISC_OFF = LDSCTL_OFF + 320, LDS_BYTES = 157696;
constexpr int LDS_ROPE = 131072, LDS_GAIN = LDS_ROPE + 256 * 16 * 4;

typedef float f32x2 __attribute__((ext_vector_type(2)));
typedef float f32x16 __attribute__((ext_vector_type(16)));
typedef short v4i16_t __attribute__((ext_vector_type(4)));
__device__ __forceinline__ float sigm(float x) { return __builtin_amdgcn_rcpf(1.f + __builtin_amdgcn_exp2f(-LOG2E * x)); }
__device__ __forceinline__ float siluf(float x) { return x * sigm(x); }
__device__ __forceinline__ float bflo(unsigned w) { return __builtin_bit_cast(float, w << 16); }
__device__ __forceinline__ float bfhi(unsigned w) { return __builtin_bit_cast(float, w & 0xffff0000u); }
__device__ __forceinline__ v4u pack8(f32x4 a, f32x4 b) { v4u w; w.x = pg8::cvt_pk_bf16(a[0], a[1]); w.y = pg8::cvt_pk_bf16(a[2], a[3]); w.z = pg8::cvt_pk_bf16(b[0], b[1]); w.w = pg8::cvt_pk_bf16(b[2], b[3]); return w; }
__device__ __forceinline__ f32x4 gelu4(f32x4 v) { const pg8::f32x2 a = pg8::gelu_pk((pg8::f32x2){v[0], v[1]}), b = pg8::gelu_pk((pg8::f32x2){v[2], v[3]}); return (f32x4){a.x, a.y, b.x, b.y}; }
__device__ __forceinline__ f32x4 silu4(f32x4 v) { return (f32x4){siluf(v[0]), siluf(v[1]), siluf(v[2]), siluf(v[3])}; }
__device__ __forceinline__ f32x4 sigm4(f32x4 v) { return (f32x4){sigm(v[0]), sigm(v[1]), sigm(v[2]), sigm(v[3])}; }

__host__ __device__ __forceinline__ int tile_lt(int pn) { return pn < 4 ? pn + 20 : pn < 6 ? pn + 20 : pn < 24 ? pn - 6 : pn < 26 ? pn - 6 : pn; }
__host__ __device__ __forceinline__ int win_srccol(int np) {
    const int pn = tile_lt(np >> 8), j = np & 255;
    if (pn < 18) { const int g = pn / 6, t = (pn % 6) >> 1, half = pn & 1; return g * 1536 + t * 512 + half * 256 + 64 * ((j & 127) >> 5) + 32 * (j >> 7) + (j & 31); }
    if (pn < 20) return 4608 + (pn - 18) * 256 + j;
    if (pn < 24) return (j < 128) ? 5120 + 128 * (pn - 20) + j : 6144 + 128 * (pn - 20) + (j - 128);
    if (pn < 26) return 5632 + (pn - 24) * 256 + j;
    return (j < 128) ? 6656 + 128 * (pn - 26) + j : 7680 + 128 * (pn - 26) + (j - 128);
}

template <bool LR  > struct EpiZT {
    static constexpr bool PERM = true, AFTER_DRAIN = false, CARRY = false;
    bf16* qkv; bf16* ga; bf16* ug; bf16* vg; bf16* ma; bf16* mb; float* stats; const float* rope; const float* qg; const float* kg; const LAS float* lrope = nullptr; const LAS float* lgain = nullptr;
    __device__ __forceinline__ void operator()(const pg8::f32x4 (&acc)[2][2][4][2], const pg8::Unit& u, int wr, int wc, int fr, int fq) const {
        const int pn = tile_lt(u.pn), row0 = u.pm * 256 + wr * 64 + fr;
        if (pn < 18) {
            const int g = pn / 6, t = (pn % 6) >> 1, head = (pn & 1) * 4 + wc, b = u.pm >> 3, dsh = 2 * g;
            bf16* base = qkv + (size_t)((((b * 3 + g) * 3 + t) * 8 + head) * 2048) * 64 + 8 * fq;
            if (t < 2) {
                const float* gbase = (t == 0 ? qg : kg) + g * 64; const float gs = (t == 0) ? QSCALE : 1.f; const bool lowq = fq < 2;
                f32x4 gn[2][2];
#pragma unroll
                for (int n = 0; n < 2; ++n) {
                    if constexpr (LR) { const LAS float* lg = lgain + (g * 2 + t) * 64; gn[0][n] = *(const LAS f32x4*)(lg + (lowq ? 8 * n + 4 * fq : 8 * fq + 4 * n)); gn[1][n] = *(const LAS f32x4*)(lg + 32 + 8 * fq + 4 * n); }
                    else { gn[0][n] = *(const f32x4*)(gbase + (lowq ? 8 * n + 4 * fq : 8 * fq + 4 * n)); gn[1][n] = *(const f32x4*)(gbase + 32 + 8 * fq + 4 * n); } }
                constexpr int RD = 3; f32x4 rc[RD], rsn[RD];
#pragma unroll
                for (int r = 0; r < (LR ? 0 : RD); ++r) { const f32x4* rp = (const f32x4*)(rope + (size_t)(row0 + (r >> 2) * 128 + (r & 3) * 16) * 16); rc[r] = rp[fq & 1]; rsn[r] = rp[2 + (fq & 1)]; }
                float rs[2][4];
#pragma unroll
                for (int ai = 0; ai < 2; ++ai)
#pragma unroll
                    for (int m = 0; m < 4; ++m) { float ss = 0.f;
#pragma unroll
                        for (int bj = 0; bj < 2; ++bj)
#pragma unroll
                            for (int n = 0; n < 2; ++n) { const f32x4 q = acc[ai][bj][m][n] * acc[ai][bj][m][n]; ss += (q[0] + q[1]) + (q[2] + q[3]); }
                        rs[ai][m] = ss; }
#pragma unroll
                for (int ai = 0; ai < 2; ++ai)
#pragma unroll
                    for (int m = 0; m < 4; ++m) rs[ai][m] += __shfl_xor(rs[ai][m], 16);
#pragma unroll
                for (int ai = 0; ai < 2; ++ai)
#pragma unroll
                    for (int m = 0; m < 4; ++m) { rs[ai][m] += __shfl_xor(rs[ai][m], 32); rs[ai][m] = __builtin_amdgcn_rsqf(rs[ai][m] * (1.f / 64.f) + EPSN); }
#pragma unroll
                for (int n = 0; n < 2; ++n) { gn[0][n] *= gs; gn[1][n] *= gs; }
#pragma unroll
                for (int ai = 0; ai < 2; ++ai)
#pragma unroll
                    for (int m = 0; m < 4; ++m) {
                        const int row = row0 + ai * 128 + m * 16, s = row & 2047, sp = ((s & ((1 << dsh) - 1)) << (11 - dsh)) + (s >> dsh);
                        const float rstd = rs[ai][m];
                        f32x4 v00 = (acc[ai][0][m][0] * rstd) * gn[0][0], v01 = (acc[ai][0][m][1] * rstd) * gn[0][1];
                        const f32x4 v10 = (acc[ai][1][m][0] * rstd) * gn[1][0], v11 = (acc[ai][1][m][1] * rstd) * gn[1][1];
                        const int r = ai * 4 + m;
                        if constexpr (LR) { const LAS f32x4* rp = (const LAS f32x4*)(lrope + (wr * 64 + fr + ai * 128 + m * 16) * 16); rc[0] = rp[fq & 1]; rsn[0] = rp[2 + (fq & 1)]; }
                        const int ri = LR ? 0 : r % RD;
                        const f32x4 r0 = v00 * rc[ri] - v01 * rsn[ri], r1 = v01 * rc[ri] + v00 * rsn[ri];
                        if (lowq) { v00 = r0; v01 = r1; }
                        const v4u p0 = pack8(v00, v01), p1 = pack8(v10, v11);
                        if constexpr (!LR) if (r + RD < 8) { const int r2 = r + RD; const f32x4* rp = (const f32x4*)(rope + (size_t)(row0 + (r2 >> 2) * 128 + (r2 & 3) * 16) * 16); rc[r % RD] = rp[fq & 1]; rsn[r % RD] = rp[2 + (fq & 1)]; }
                        asm volatile("" ::: "memory");
                        bf16* dst = base + (size_t)sp * 64;
                        *(v4u*)(dst) = p0; *(v4u*)(dst + 32) = p1;
                        if (m & 1) asm volatile("" ::: "memory");
                    }
            } else {
#pragma unroll
                for (int ai = 0; ai < 2; ++ai)
#pragma unroll
                    for (int m = 0; m < 4; ++m) {
                        const int row = row0 + ai * 128 + m * 16, s = row & 2047, sp = ((s & ((1 << dsh) - 1)) << (11 - dsh)) + (s >> dsh);
                        bf16* dst = base + (size_t)sp * 64;
                        *(v4u*)(dst) = pack8(acc[ai][0][m][0], acc[ai][0][m][1]); *(v4u*)(dst + 32) = pack8(acc[ai][1][m][0], acc[ai][1][m][1]);
                    }
            }
        } else if (pn < 20) {
            bf16* basep = ga + (pn - 18) * 256 + wc * 32 + 8 * fq;
#pragma unroll
            for (int ai = 0; ai < 2; ++ai)
#pragma unroll
                for (int m = 0; m < 4; ++m) { bf16* dst = basep + (size_t)(row0 + ai * 128 + m * 16) * 512;
#pragma unroll
                    for (int bj = 0; bj < 2; ++bj) *(v4u*)(dst + bj * 128) = pack8(silu4(acc[ai][bj][m][0]), silu4(acc[ai][bj][m][1])); }
        } else if (pn < 24) {
            bf16* basep = ug + (pn - 20) * 128 + wc * 32 + 8 * fq;
#pragma unroll
            for (int ai = 0; ai < 2; ++ai)
#pragma unroll
                for (int m = 0; m < 4; ++m) { bf16* dst = basep + (size_t)(row0 + ai * 128 + m * 16) * 512;
                    *(v4u*)(dst) = pack8(gelu4(acc[ai][0][m][0]) * silu4(acc[ai][1][m][0]), gelu4(acc[ai][0][m][1]) * silu4(acc[ai][1][m][1])); }
        } else if (pn < 26) {
            bf16* basep = vg + (pn - 24) * 256 + wc * 32 + 8 * fq;
#pragma unroll
            for (int ai = 0; ai < 2; ++ai)
#pragma unroll
                for (int m = 0; m < 4; ++m) { const int row = row0 + ai * 128 + m * 16; bf16* dst = basep + (size_t)row * 512; float s1 = 0.f, s2 = 0.f;
#pragma unroll
                    for (int bj = 0; bj < 2; ++bj) { const f32x4 a = gelu4(acc[ai][bj][m][0]), c = gelu4(acc[ai][bj][m][1]);
                        s1 += ((a[0] + a[1]) + (a[2] + a[3])) + ((c[0] + c[1]) + (c[2] + c[3]));
                        const f32x4 a2 = a * a, c2 = c * c; s2 += ((a2[0] + a2[1]) + (a2[2] + a2[3])) + ((c2[0] + c2[1]) + (c2[2] + c2[3]));
                        *(v4u*)(dst + bj * 128) = pack8(a, c); }
                    s1 += __shfl_xor(s1, 16); s1 += __shfl_xor(s1, 32); s2 += __shfl_xor(s2, 16); s2 += __shfl_xor(s2, 32);
                    if (fq == 0) *(f32x2*)(stats + ((size_t)row * 8 + (pn - 24) * 4 + wc) * 2) = (f32x2){s1, s2}; }
        } else {
            const int cb = (pn - 26) * 128 + wc * 32 + 8 * fq;
#pragma unroll
            for (int ai = 0; ai < 2; ++ai)
#pragma unroll
                for (int m = 0; m < 4; ++m) { const size_t ro = ovl_row(row0 + ai * 128 + m * 16) + cb;
                    f32x4 a0 = sigm4(acc[ai][0][m][0]), a1 = sigm4(acc[ai][0][m][1]), b0 = sigm4(acc[ai][1][m][0]), b1 = sigm4(acc[ai][1][m][1]);
#pragma unroll
                    for (int e = 0; e < 4; ++e) { b0[e] = fmaxf(b0[e], 1e-18f); b1[e] = fmaxf(b1[e], 1e-18f); a0[e] *= __builtin_amdgcn_rcpf(b0[e]); a1[e] *= __builtin_amdgcn_rcpf(b1[e]); }
                    *(v4u*)(ma + ro) = pack8(a0, a1); *(v4u*)(mb + ro) = pack8(b0, b1); }
        }
    }
};
typedef EpiZT<false> EpiZ;
struct EpiMrg {
    static constexpr bool PERM = true, AFTER_DRAIN = false, CARRY = true;
    const bf16* rat; const bf16* fin; bf16* merged;
    __device__ __forceinline__ bool carry(const pg8::Unit& u) const { return u.pm < 64; }
    __device__ __forceinline__ void operator()(pg8::f32x4 (&acc)[2][2][4][2], const pg8::Unit& u, int wr, int wc, int fr, int fq) const {
        const bool first = u.pm < 64; const int pm = u.pm & 63, pn = u.pn & 3;
        const int row0 = pm * 256 + wr * 64 + fr, col0 = pn * 256 + wc * 32 + 8 * fq;
        const bf16* gsrc = first ? rat : fin;
        constexpr int GD = 3; v4u gr[GD][2];
#pragma unroll
        for (int r = 0; r < GD; ++r) { const size_t ro = ovl_row(row0 + (r >> 2) * 128 + (r & 3) * 16) + col0; gr[r][0] = *(const v4u*)(gsrc + ro); gr[r][1] = *(const v4u*)(gsrc + ro + 128); }
#pragma unroll
        for (int r = 0; r < 8; ++r) { const int ai = r >> 2, m = r & 3; const size_t ro = ovl_row(row0 + ai * 128 + m * 16) + col0;
            v4u o[2];
#pragma unroll
            for (int bj = 0; bj < 2; ++bj) { const v4u gw = gr[r % GD][bj];
                const f32x4 g0 = {bflo(gw.x), bfhi(gw.x), bflo(gw.y), bfhi(gw.y)}, g1 = {bflo(gw.z), bfhi(gw.z), bflo(gw.w), bfhi(gw.w)};
                if (first) { acc[ai][bj][m][0] *= g0; acc[ai][bj][m][1] *= g1; }
                else o[bj] = pack8(g0 * acc[ai][bj][m][0], g1 * acc[ai][bj][m][1]); }
            if (r + GD < 8) { const int r2 = r + GD; const size_t ro2 = ovl_row(row0 + (r2 >> 2) * 128 + (r2 & 3) * 16) + col0; gr[r % GD][0] = *(const v4u*)(gsrc + ro2); gr[r % GD][1] = *(const v4u*)(gsrc + ro2 + 128); }
            asm volatile("" ::: "memory");
            if (!first) { *(v4u*)(merged + ro) = o[0]; *(v4u*)(merged + ro + 128) = o[1]; }
        }
    }
};
struct EpiOut {
    static constexpr bool PERM = true, AFTER_DRAIN = false, CARRY = false;
    const float* x; const float* ada; float* out;
    __device__ __forceinline__ void operator()(const pg8::f32x4 (&acc)[2][2][4][2], const pg8::Unit& u, int wr, int wc, int fr, int fq) const {
        const int row0 = u.pm * 256 + wr * 64 + fr, col0 = u.pn * 256 + wc * 32 + 8 * fq, b = u.pm >> 3;
        f32x4 gt[2][2];
#pragma unroll
        for (int bj = 0; bj < 2; ++bj)
#pragma unroll
            for (int n = 0; n < 2; ++n) gt[bj][n] = *(const f32x4*)(ada + b * 3072 + 2048 + col0 + bj * 128 + 4 * n);
        constexpr int XD = 2; f32x4 xr[XD][2][2];
#pragma unroll
        for (int r = 0; r < XD; ++r) { const size_t ro = (size_t)(row0 + (r >> 2) * 128 + (r & 3) * 16) * 1024 + col0;
#pragma unroll
            for (int bj = 0; bj < 2; ++bj)
#pragma unroll
                for (int n = 0; n < 2; ++n) xr[r][bj][n] = *(const f32x4*)(x + ro + bj * 128 + 4 * n); }
#pragma unroll
        for (int r = 0; r < 8; ++r) { const int ai = r >> 2, m = r & 3; const size_t ro = (size_t)(row0 + ai * 128 + m * 16) * 1024 + col0;
            f32x4 o[2][2];
#pragma unroll
            for (int bj = 0; bj < 2; ++bj)
#pragma unroll
                for (int n = 0; n < 2; ++n) o[bj][n] = xr[r % XD][bj][n] + gt[bj][n] * acc[ai][bj][m][n];
            if (r + XD < 8) { const int r2 = r + XD; const size_t ro2 = (size_t)(row0 + (r2 >> 2) * 128 + (r2 & 3) * 16) * 1024 + col0;
#pragma unroll
                for (int bj = 0; bj < 2; ++bj)
#pragma unroll
                    for (int n = 0; n < 2; ++n) xr[r % XD][bj][n] = *(const f32x4*)(x + ro2 + bj * 128 + 4 * n); }
            asm volatile("" ::: "memory");
#pragma unroll
            for (int bj = 0; bj < 2; ++bj)
#pragma unroll
                for (int n = 0; n < 2; ++n) *(f32x4*)(out + ro + bj * 128 + 4 * n) = o[bj][n];
        }
    }
};
struct MergeOrder {
    int G, c;
    __device__ __forceinline__ bool next(int i, pg8::Unit& u) const {
        const int p = (i >> 1) * G + c; if (p >= 256) return false;
        const int x = p & 7, idx = p >> 3; u.pm = 8 * x + (idx & 7); u.pn = 26 + 2 * (idx >> 3) + (i & 1); return true;
    }
    __device__ __forceinline__ void a_ready(const pg8::Unit&) const {}
    __device__ __forceinline__ void done(const pg8::Unit&) const {}
};
constexpr unsigned NWAVES_HOOK = 8;
struct RangeOrder {
    pg8::StaticOrder S; int i0, n;
    int hook_after = 0; XcdBarrier hb{}; volatile LAS unsigned* wcnt = nullptr; mutable int ndone = 0;
    __device__ __forceinline__ bool next(int i, pg8::Unit& u) const { return i < n && S.next(i0 + i, u); }
    __device__ __forceinline__ void a_ready(const pg8::Unit&) const {}
    __device__ __forceinline__ void done(const pg8::Unit&) const {
        if (++ndone != hook_after) return;
        asm volatile("s_waitcnt vmcnt(0)" ::: "memory");
        unsigned c = 0u; if ((threadIdx.x & 63) == 0) c = __hip_atomic_fetch_add((LAS unsigned*)wcnt, 1u, __ATOMIC_RELAXED, __HIP_MEMORY_SCOPE_WORKGROUP);
        c = (unsigned)__builtin_amdgcn_readfirstlane((int)c);
        if (c == NWAVES_HOOK - 1 && (threadIdx.x & 63) == 0) xcd_local_arrive(hb);
    }
};
struct PairOrder {
    int G, c;
    __device__ __forceinline__ bool next(int i, pg8::Unit& u) const {
        const int p = (i >> 1) * G + c; if (p >= 256) return false;
        const int x = p & 7, idx = p >> 3; int pm = 8 * x + (idx & 7), pn = idx >> 3;
        if (i & 1) { pm += 64; pn += 4; }
        u.pm = pm; u.pn = pn; return true;
    }
    __device__ __forceinline__ void a_ready(const pg8::Unit&) const {}
    __device__ __forceinline__ void done(const pg8::Unit&) const {}
};

namespace att {
__device__ __forceinline__ int crow(int r, int hi) { return (r & 3) + 8 * (r >> 2) + 4 * hi; }
__device__ __forceinline__ v4i16_t vtr(const LAS unsigned char* p) { return __builtin_amdgcn_ds_read_tr16_b64_v4i16((LAS v4i16_t*)p); }
}


namespace att2 {
constexpr int KR = 0, VR = 49152, XO = 98304, XL = 131072, XL2 = 132096, QB = 133120, NITEM = 8 * 3 * 8 * 16;
#define A2_LGKM() asm volatile("s_waitcnt lgkmcnt(0)" ::: "memory")
#define A2_BAR() do { asm volatile("s_waitcnt lgkmcnt(0)" ::: "memory"); __builtin_amdgcn_s_barrier(); asm volatile("" ::: "memory"); } while (0)
__device__ __forceinline__ void glds16(const void* gsrc, unsigned lds_dst) { unsigned keep;
    asm volatile("s_mov_b32 %0, m0\n\ts_mov_b32 m0, %2\n\ts_nop 0\n\tglobal_load_lds_dwordx4 %1, off\n\ts_mov_b32 m0, %0" : "=&s"(keep) : "v"(gsrc), "s"(lds_dst) : "memory"); }
__device__ __forceinline__ void issue_dma(int a, int k, int tau0, bf16* qkv, unsigned lds0, int wid, int lane) {
    const int n16 = a & 15, h = (a >> 4) & 7, bg = a >> 7, g = bg % 3, Lsh = 11 - 2 * g, cs = ((128 * n16) >> Lsh) << Lsh, sbase = 128 * n16 - 128;
    const bf16* Ks = qkv + (size_t)((bg * 3 * 8 + 8 + h) * 2048) * 64; const bf16* Vs = Ks + (size_t)8 * 2048 * 64;
#pragma unroll
    for (int tile = 0; tile < 4; ++tile) { const int ks0 = sbase + 64 * tile;
        if (tile >= tau0 && ks0 >= cs) { const int slot = (2 * k + tile) % 6;
            glds16(Ks + (size_t)(ks0 + lane) * 64 + wid * 8, (unsigned)__builtin_amdgcn_readfirstlane((int)(lds0 + KR + slot * 8192 + wid * 1024)));
            glds16(Vs + (size_t)(ks0 + 16 * (wid & 3) + (lane >> 2)) * 64 + (wid >> 2) * 32 + (lane & 3) * 8, (unsigned)__builtin_amdgcn_readfirstlane((int)(lds0 + VR + slot * 8192 + wid * 1024)));
        } }
}
__device__ __forceinline__ void issue_q(int a, const bf16* qkv, unsigned lds0, int wid, int lane) {
    const int n16 = a & 15, h = (a >> 4) & 7, bg = a >> 7; const bf16* Qs = qkv + (size_t)((bg * 3 * 8 + h) * 2048) * 64 + (size_t)(128 * n16) * 64;
#pragma unroll
    for (int rh = 0; rh < 2; ++rh) glds16(Qs + (size_t)(rh * 64 + lane) * 64 + wid * 8, (unsigned)__builtin_amdgcn_readfirstlane((int)(lds0 + QB + (rh * 8 + wid) * 1024)));
}
__device__ __forceinline__ void attn_phase(int a0, int cnt, bf16* qkv, float* lse, const float* ref2tab, LAS unsigned char* lds) {
    const int tid = threadIdx.x, lane = tid & 63, r32 = lane & 31, hi = lane >> 5, wid = __builtin_amdgcn_readfirstlane(tid >> 6);
    const int qg = wid & 3, half = wid >> 2, qodd = qg & 1, c = 32 * qodd + r32;
    const float rf0 = __hip_atomic_load(ref2tab + 0, __ATOMIC_RELAXED, __HIP_MEMORY_SCOPE_AGENT), rf1 = __hip_atomic_load(ref2tab + 1, __ATOMIC_RELAXED, __HIP_MEMORY_SCOPE_AGENT), rf2 = __hip_atomic_load(ref2tab + 2, __ATOMIC_RELAXED, __HIP_MEMORY_SCOPE_AGENT);
    if (cnt <= 0) return;
    __syncthreads();
    const unsigned lds0 = (unsigned)(uintptr_t)(unsigned char*)lds;
    bf16x8 qr[4];
    issue_dma(a0, 0, 0, qkv, lds0, wid, lane); issue_q(a0, qkv, lds0, wid, lane);
    for (int k = 0; k < cnt; ++k) {
        const int a = a0 + k;
        if (k == 0) asm volatile("s_waitcnt vmcnt(0)" ::: "memory"); else if (half) asm volatile("s_waitcnt vmcnt(2)" ::: "memory"); else asm volatile("s_waitcnt vmcnt(3)" ::: "memory");
        A2_BAR();
        { const LAS unsigned char* qb = lds + QB + ((qg >> 1) * 8 + hi) * 1024 + (32 * (qg & 1) + r32) * 16;
#pragma unroll
          for (int d0 = 0; d0 < 4; ++d0) qr[d0] = *(const LAS bf16x8*)(qb + d0 * 2048); }
        A2_BAR();
        const bool has_next = k + 1 < cnt;
        if (has_next) { issue_dma(a + 1, k + 1, 2, qkv, lds0, wid, lane); issue_q(a + 1, qkv, lds0, wid, lane); }
        const int n16 = a & 15, h = (a >> 4) & 7, bg = a >> 7, g = bg % 3, b = bg / 3, Lsh = 11 - 2 * g, cs = ((128 * n16) >> Lsh) << Lsh, sbase = 128 * n16 - 128;
        const float ref2 = (g == 0) ? rf0 : (g == 1) ? rf1 : rf2;
        const LAS unsigned char* kbase = lds + KR + hi * 1024 + r32 * 16;
        const LAS unsigned char* vbase = lds + VR + ((lane >> 4) & 1) * 32 + (lane & 3) * 8 + (4 * hi + ((lane & 15) >> 2)) * 64;
        f32x16 o0, o1;
#pragma unroll
        for (int r = 0; r < 16; ++r) { o0[r] = 0.f; o1[r] = 0.f; }
        float l = 0.f;
#define A2_STEP(S, HS, MODE) do { const int tile_ = (qg >> 1) + (S); if (sbase + 64 * tile_ >= cs) { const int so_ = ((2 * k + tile_) % 6) * 8192; \
            f32x16 p_; _Pragma("unroll") for (int r = 0; r < 16; ++r) p_[r] = -ref2; \
            _Pragma("unroll") for (int d0 = 0; d0 < 4; ++d0) { const bf16x8 kf_ = *(const LAS bf16x8*)(kbase + so_ + d0 * 2048 + (HS) * 512); p_ = __builtin_amdgcn_mfma_f32_32x32x16_bf16(kf_, qr[d0], p_, 0, 0, 0); } \
            _Pragma("unroll") for (int r = 0; r < 16; ++r) { const int kvl_ = att::crow(r, hi) + 32 * (HS); const bool v_ = ((MODE) == 0) ? true : ((MODE) == 1) ? (kvl_ >= c) : (kvl_ <= c); \
                const float e_ = v_ ? __builtin_amdgcn_exp2f(p_[r]) : 0.f; p_[r] = e_; l += e_; } \
            const v4u w0_ = {pg8::cvt_pk_bf16(p_[0], p_[1]), pg8::cvt_pk_bf16(p_[2], p_[3]), pg8::cvt_pk_bf16(p_[4], p_[5]), pg8::cvt_pk_bf16(p_[6], p_[7])}; \
            const v4u w1_ = {pg8::cvt_pk_bf16(p_[8], p_[9]), pg8::cvt_pk_bf16(p_[10], p_[11]), pg8::cvt_pk_bf16(p_[12], p_[13]), pg8::cvt_pk_bf16(p_[14], p_[15])}; \
            _Pragma("unroll") for (int j_ = 0; j_ < 2; ++j_) { const bf16x8 pa_ = __builtin_bit_cast(bf16x8, j_ ? w1_ : w0_); const int ko_ = so_ + (2 * (HS) + j_) * 1024; \
                { const v4i16_t lo_ = att::vtr(vbase + ko_), hh_ = att::vtr(vbase + ko_ + 512); o0 = __builtin_amdgcn_mfma_f32_32x32x16_bf16(pa_, (bf16x8){lo_[0], lo_[1], lo_[2], lo_[3], hh_[0], hh_[1], hh_[2], hh_[3]}, o0, 0, 0, 0); } \
                { const v4i16_t lo_ = att::vtr(vbase + ko_ + 4096), hh_ = att::vtr(vbase + ko_ + 4096 + 512); o1 = __builtin_amdgcn_mfma_f32_32x32x16_bf16(pa_, (bf16x8){lo_[0], lo_[1], lo_[2], lo_[3], hh_[0], hh_[1], hh_[2], hh_[3]}, o1, 0, 0, 0); } } \
        } } while (0)
        if (!qodd) { if (!half) { A2_STEP(0, 0, 1); A2_STEP(0, 1, 0); A2_STEP(1, 0, 0); } else { A2_STEP(1, 1, 0); A2_STEP(2, 0, 2); } }
        else       { if (!half) { A2_STEP(0, 1, 1); A2_STEP(1, 0, 0); A2_STEP(1, 1, 0); } else { A2_STEP(2, 0, 0); A2_STEP(2, 1, 2); } }
#undef A2_STEP
        LAS f32x4* xo = (LAS f32x4*)(lds + XO); LAS float* xl = (LAS float*)(lds + XL); LAS float* xl2 = (LAS float*)(lds + XL2);
#pragma unroll
        for (int q4 = 0; q4 < 4; ++q4) xo[((qg * 2 + (half ^ 1)) * 4 + q4) * 64 + lane] = half ? (f32x4){o0[4 * q4], o0[4 * q4 + 1], o0[4 * q4 + 2], o0[4 * q4 + 3]} : (f32x4){o1[4 * q4], o1[4 * q4 + 1], o1[4 * q4 + 2], o1[4 * q4 + 3]};
        xl[(qg * 2 + half) * 64 + lane] = l;
        A2_BAR();
        {
            f32x16 om;
#pragma unroll
            for (int q4 = 0; q4 < 4; ++q4) { const f32x4 u = xo[((qg * 2 + half) * 4 + q4) * 64 + lane];
#pragma unroll
                for (int e = 0; e < 4; ++e) om[4 * q4 + e] = (half ? o1[4 * q4 + e] : o0[4 * q4 + e]) + u[e]; }
            l += xl[(qg * 2 + (half ^ 1)) * 64 + lane];
            l += __shfl_xor(l, 32);
            if (hi == 0) xl2[(qg * 2 + half) * 32 + r32] = l;
            A2_LGKM();
            LAS bf16* stg = (LAS bf16*)(lds + XO) + (qg * 2 + half) * 2048;
#pragma unroll
            for (int r = 0; r < 16; ++r) { const int orow = att::crow(r, hi); stg[orow * 32 + r32] = (bf16)f2bf(om[r] * __builtin_amdgcn_rcpf(xl2[(qg * 2 + half) * 32 + orow])); }
            A2_LGKM();
            bf16* Ow = qkv + (size_t)((bg * 3 * 8 + h) * 2048) * 64 + (size_t)(128 * n16 + 32 * qg) * 64 + half * 32;
#pragma unroll
            for (int i = 0; i < 2; ++i) { const int row = i * 16 + (lane >> 2), ch = lane & 3; const v4u v = *(const LAS v4u*)(stg + row * 32 + ch * 8); *(v4u*)(Ow + (size_t)row * 64 + ch * 8) = v; }
            if (!half && hi == 0) lse[((size_t)(g * 8 + b) * 8 + h) * 2048 + 128 * n16 + 32 * qg + r32] = (__builtin_amdgcn_logf(l) + ref2) * LN2;
        }
    }
    A2_LGKM(); __syncthreads();
}
}

__device__ __forceinline__ void gmlp_item(int idx, const bf16* vg, bf16* ug, const float* stats, const bf16* wsp, const float* bsp, const float* lng, const float* lnb, LAS unsigned char* lds) {
    const int tid = threadIdx.x, lane = tid & 63, r32 = lane & 31, hi = lane >> 5, wid = __builtin_amdgcn_readfirstlane(tid >> 6);
    const int g = idx & 7, nc = (idx >> 3) & 15, b = idx >> 7, tok0 = b * 2048 + nc * 128, c0 = 64 * g;
    const int s = tid >> 2, part = tid & 3; const size_t tok = (size_t)tok0 + s;
    constexpr int SVOFF = 16384, SVP = 65;
    __syncthreads();
    {
        const f32x4* sp = (const f32x4*)(stats + tok * 16); const f32x4 a0 = sp[0], a1 = sp[1], a2 = sp[2], a3 = sp[3];
        const float s1 = ((a0[0] + a0[2]) + (a1[0] + a1[2])) + ((a2[0] + a2[2]) + (a3[0] + a3[2])), s2 = ((a0[1] + a0[3]) + (a1[1] + a1[3])) + ((a2[1] + a2[3]) + (a3[1] + a3[3]));
        const float mean = s1 * (1.f / 512.f), var = fmaxf(s2 * (1.f / 512.f) - mean * mean, 0.f), rstd = __builtin_amdgcn_rsqf(var + EPSN);
        const v4u* vp = (const v4u*)(vg + tok * 512 + c0 + part * 16); const v4u w0 = vp[0], w1 = vp[1];
        const f32x4* gp = (const f32x4*)(lng + c0 + part * 16); const f32x4* bp = (const f32x4*)(lnb + c0 + part * 16);
        f32x4 x0 = {bflo(w0.x), bfhi(w0.x), bflo(w0.y), bfhi(w0.y)}, x1 = {bflo(w0.z), bfhi(w0.z), bflo(w0.w), bfhi(w0.w)};
        f32x4 x2 = {bflo(w1.x), bfhi(w1.x), bflo(w1.y), bfhi(w1.y)}, x3 = {bflo(w1.z), bfhi(w1.z), bflo(w1.w), bfhi(w1.w)};
        x0 = ((x0 - mean) * rstd) * gp[0] + bp[0]; x1 = ((x1 - mean) * rstd) * gp[1] + bp[1]; x2 = ((x2 - mean) * rstd) * gp[2] + bp[2]; x3 = ((x3 - mean) * rstd) * gp[3] + bp[3];
        LAS unsigned char* dst = lds + (s >> 6) * 8192 + (part >> 1) * 4096 + ((s & 63) >> 4) * 1024 + (s & 15) * 64 + (part & 1) * 32;
        *(LAS v4u*)(dst) = pack8(x0, x1); *(LAS v4u*)(dst + 16) = pack8(x2, x3);
    }
    __syncthreads();
    {
        const int tt = wid >> 1, ct = wid & 1;
        f32x16 acc;
#pragma unroll
        for (int r = 0; r < 16; ++r) acc[r] = 0.f;
        const bf16* wrow = wsp + (size_t)(g * 128 + 32 * tt + r32) * 128 + 8 * hi;
        const LAS unsigned char* bb = lds + ct * 4096 + (8 * hi + ((lane & 15) >> 2)) * 64 + ((lane >> 4) & 1) * 32 + (lane & 3) * 8;
#pragma unroll
        for (int ks = 0; ks < 8; ++ks) if (ks < 2 * (tt + 1)) {
            const bf16x8 A = *(const bf16x8*)(wrow + 16 * ks);
            const LAS unsigned char* b2 = bb + (ks >> 2) * 8192 + (ks & 3) * 1024;
            const v4i16_t lo = att::vtr(b2), hh = att::vtr(b2 + 256);
            acc = __builtin_amdgcn_mfma_f32_32x32x16_bf16(A, (bf16x8){lo[0], lo[1], lo[2], lo[3], hh[0], hh[1], hh[2], hh[3]}, acc, 0, 0, 0);
        }
        LAS float* sv = (LAS float*)(lds + SVOFF);
#pragma unroll
        for (int r = 0; r < 16; ++r) sv[(32 * tt + att::crow(r, hi)) * SVP + 32 * ct + r32] = acc[r];
    }
    __syncthreads();
    {
        const LAS float* sv = (const LAS float*)(lds + SVOFF) + s * SVP + part * 16; const float bs = bsp[g * 128 + s];
        bf16* up = ug + tok * 512 + c0 + part * 16; const v4u w0 = *(const v4u*)up, w1 = *(const v4u*)(up + 8);
        f32x4 y0 = {bflo(w0.x) * (sv[0] + bs), bfhi(w0.x) * (sv[1] + bs), bflo(w0.y) * (sv[2] + bs), bfhi(w0.y) * (sv[3] + bs)};
        f32x4 y1 = {bflo(w0.z) * (sv[4] + bs), bfhi(w0.z) * (sv[5] + bs), bflo(w0.w) * (sv[6] + bs), bfhi(w0.w) * (sv[7] + bs)};
        f32x4 y2 = {bflo(w1.x) * (sv[8] + bs), bfhi(w1.x) * (sv[9] + bs), bflo(w1.y) * (sv[10] + bs), bfhi(w1.y) * (sv[11] + bs)};
        f32x4 y3 = {bflo(w1.z) * (sv[12] + bs), bfhi(w1.z) * (sv[13] + bs), bflo(w1.w) * (sv[14] + bs), bfhi(w1.w) * (sv[15] + bs)};
        *(v4u*)up = pack8(y0, y1); *(v4u*)(up + 8) = pack8(y2, y3);
    }
}


__device__ __forceinline__ float wave_sum(float v);


constexpr int G2_STRIDE = 49664;
__device__ __forceinline__ void gmlp_items2(int idx0, int idx1, const bf16* vg, bf16* ug, const float* stats, const bf16* wsp, const float* bsp, const float* lng, const float* lnb, LAS unsigned char* lds) {
    const int tid = threadIdx.x, lane = tid & 63, r32 = lane & 31, hi = lane >> 5, wid = __builtin_amdgcn_readfirstlane(tid >> 6);
    const int s = tid >> 2, part = tid & 3;
    constexpr int SVOFF = 16384, SVP = 65;
    int gg[2], c0[2]; size_t tok[2]; v4u uw0[2], uw1[2]; float bs[2];
#pragma unroll
    for (int j = 0; j < 2; ++j) { const int idx = j ? idx1 : idx0; gg[j] = idx & 7; c0[j] = 64 * gg[j]; tok[j] = (size_t)((idx >> 7) * 2048 + ((idx >> 3) & 15) * 128) + s; }
    __syncthreads();
#pragma unroll
    for (int j = 0; j < 2; ++j) {
        const f32x4* sp = (const f32x4*)(stats + tok[j] * 16); const f32x4 a0 = sp[0], a1 = sp[1], a2 = sp[2], a3 = sp[3];
        const v4u* vp = (const v4u*)(vg + tok[j] * 512 + c0[j] + part * 16); const v4u w0 = vp[0], w1 = vp[1];
        const bf16* up = ug + tok[j] * 512 + c0[j] + part * 16; uw0[j] = *(const v4u*)up; uw1[j] = *(const v4u*)(up + 8); bs[j] = bsp[gg[j] * 128 + s];
        const float s1 = ((a0[0] + a0[2]) + (a1[0] + a1[2])) + ((a2[0] + a2[2]) + (a3[0] + a3[2])), s2 = ((a0[1] + a0[3]) + (a1[1] + a1[3])) + ((a2[1] + a2[3]) + (a3[1] + a3[3]));
        const float mean = s1 * (1.f / 512.f), var = fmaxf(s2 * (1.f / 512.f) - mean * mean, 0.f), rstd = __builtin_amdgcn_rsqf(var + EPSN);
        const f32x4* gp = (const f32x4*)(lng + c0[j] + part * 16); const f32x4* bp = (const f32x4*)(lnb + c0[j] + part * 16);
        f32x4 x0 = {bflo(w0.x), bfhi(w0.x), bflo(w0.y), bfhi(w0.y)}, x1 = {bflo(w0.z), bfhi(w0.z), bflo(w0.w), bfhi(w0.w)};
        f32x4 x2 = {bflo(w1.x), bfhi(w1.x), bflo(w1.y), bfhi(w1.y)}, x3 = {bflo(w1.z), bfhi(w1.z), bflo(w1.w), bfhi(w1.w)};
        x0 = ((x0 - mean) * rstd) * gp[0] + bp[0]; x1 = ((x1 - mean) * rstd) * gp[1] + bp[1]; x2 = ((x2 - mean) * rstd) * gp[2] + bp[2]; x3 = ((x3 - mean) * rstd) * gp[3] + bp[3];
        LAS unsigned char* dst = lds + j * G2_STRIDE + (s >> 6) * 8192 + (part >> 1) * 4096 + ((s & 63) >> 4) * 1024 + (s & 15) * 64 + (part & 1) * 32;
        *(LAS v4u*)(dst) = pack8(x0, x1); *(LAS v4u*)(dst + 16) = pack8(x2, x3);
    }
    __syncthreads();
    {
        const int tt = wid >> 1, ct = wid & 1;
#pragma unroll
        for (int j = 0; j < 2; ++j) {
            f32x16 acc;
#pragma unroll
            for (int r = 0; r < 16; ++r) acc[r] = 0.f;
            const bf16* wrow = wsp + (size_t)(gg[j] * 128 + 32 * tt + r32) * 128 + 8 * hi;
            const LAS unsigned char* bb = lds + j * G2_STRIDE + ct * 4096 + (8 * hi + ((lane & 15) >> 2)) * 64 + ((lane >> 4) & 1) * 32 + (lane & 3) * 8;
#pragma unroll
            for (int ks = 0; ks < 8; ++ks) if (ks < 2 * (tt + 1)) {
                const bf16x8 A = *(const bf16x8*)(wrow + 16 * ks);
                const LAS unsigned char* b2 = bb + (ks >> 2) * 8192 + (ks & 3) * 1024;
                const v4i16_t lo = att::vtr(b2), hh = att::vtr(b2 + 256);
                acc = __builtin_amdgcn_mfma_f32_32x32x16_bf16(A, (bf16x8){lo[0], lo[1], lo[2], lo[3], hh[0], hh[1], hh[2], hh[3]}, acc, 0, 0, 0);
            }
            LAS float* sv = (LAS float*)(lds + j * G2_STRIDE + SVOFF);
#pragma unroll
            for (int r = 0; r < 16; ++r) sv[(32 * tt + att::crow(r, hi)) * SVP + 32 * ct + r32] = acc[r];
        }
    }
    __syncthreads();
#pragma unroll
    for (int j = 0; j < 2; ++j) {
        const LAS float* sv = (const LAS float*)(lds + j * G2_STRIDE + SVOFF) + s * SVP + part * 16; const float b_ = bs[j];
        bf16* up = ug + tok[j] * 512 + c0[j] + part * 16; const v4u w0 = uw0[j], w1 = uw1[j];
        f32x4 y0 = {bflo(w0.x) * (sv[0] + b_), bfhi(w0.x) * (sv[1] + b_), bflo(w0.y) * (sv[2] + b_), bfhi(w0.y) * (sv[3] + b_)};
        f32x4 y1 = {bflo(w0.z) * (sv[4] + b_), bfhi(w0.z) * (sv[5] + b_), bflo(w0.w) * (sv[6] + b_), bfhi(w0.w) * (sv[7] + b_)};
        f32x4 y2 = {bflo(w1.x) * (sv[8] + b_), bfhi(w1.x) * (sv[9] + b_), bflo(w1.y) * (sv[10] + b_), bfhi(w1.y) * (sv[11] + b_)};
        f32x4 y3 = {bflo(w1.z) * (sv[12] + b_), bfhi(w1.z) * (sv[13] + b_), bflo(w1.w) * (sv[14] + b_), bfhi(w1.w) * (sv[15] + b_)};
        *(v4u*)up = pack8(y0, y1); *(v4u*)(up + 8) = pack8(y2, y3);
    }
}

struct Args { const float* x; const float* c; const int* pos; const float* norm_g; const float* w_ada; const float* b_ada; const float* w_in; const float* qg; const float* kg;
              const float* lng; const float* lnb; const float* wsp; const float* bsp; const float* wa; const float* wb; const float* wout;
              float* out; unsigned char* ws; int ph_lo, ph_hi, li, pad; };

__device__ __forceinline__ float wave_sum(float v) {
#pragma unroll
    for (int o = 1; o < 64; o <<= 1) v += __shfl_xor(v, o);
    return v;
}
__host__ __device__ __forceinline__ int qk_perm(int p) { return p < 16 ? ((p & 4) << 1) | ((p & 8) >> 1) | (p & 3) : p; }
__device__ __forceinline__ void transpose_item(const float* W, int K, int N, bf16* WT, int src0, int dst0, int k0, LAS float* scr, int lane, bool permq = false) {
#pragma unroll 32
    for (int i = 0; i < 32; ++i) { const int kk = 2 * i + (lane >> 5); scr[kk * 33 + (lane & 31)] = W[(size_t)(k0 + kk) * N + src0 + (lane & 31)]; }
    LDS_WAIT(); asm volatile("" ::: "memory");
    const int c = lane & 7;
#pragma unroll
    for (int j = 0; j < 4; ++j) { const int n = (lane >> 3) + 8 * j; const LAS float* s = scr + (8 * c) * 33 + (permq ? qk_perm(n) : n);
        v4u o; o.x = pk2(s[0 * 33], s[1 * 33]); o.y = pk2(s[2 * 33], s[3 * 33]); o.z = pk2(s[4 * 33], s[5 * 33]); o.w = pk2(s[6 * 33], s[7 * 33]);
        *(GAS v4u*)(WT + (size_t)(dst0 + n) * K + k0 + 8 * c) = o; }
    LDS_WAIT(); asm volatile("" ::: "memory");
}

__global__ void __launch_bounds__(NWAVES * 64, 2) fwd_kernel(Args args) {
    extern __shared__ __attribute__((aligned(16))) unsigned char lds_raw[];
    LAS unsigned char* lds = (LAS unsigned char*)lds_raw;
    volatile LAS unsigned* MISC = (volatile LAS unsigned*)(lds + MISC_OFF);
    const int tid = threadIdx.x, lane = tid & 63, wave = __builtin_amdgcn_readfirstlane(tid >> 6);
    const int G = gridDim.x; const int bx = blockIdx.x; const int vcu = (G % 8 == 0) ? (bx % 8) * (G / 8) + bx / 8 : bx;
    unsigned char* ws = args.ws;
    gu32* ctl = (gu32*)(ws + WS_CTL);
    float* ada = (float*)(ws + WS_ADA); float* ref2tab = (float*)(ws + WS_MISC); bf16* wspb = (bf16*)(ws + WS_WSP); float* lse = (float*)(ws + WS_LSE);
    float* stats = (float*)(ws + WS_STATS); float* rope = (float*)(ws + WS_ROPE);
    bf16* win_t = (bf16*)(ws + WS_WIN); bf16* wa_t = (bf16*)(ws + WS_WA); bf16* wb_t = (bf16*)(ws + WS_WB); bf16* wout_t = (bf16*)(ws + WS_WOUT);
    bf16* qkv = (bf16*)(ws + WS_QKV); bf16* ga = (bf16*)(ws + WS_GA); bf16* ug = (bf16*)(ws + WS_UG); bf16* vg = (bf16*)(ws + WS_VG); bf16* mb = (bf16*)(ws + WS_MBO);
    bf16* merged = (bf16*)(ws + WS_MERGED);
    bf16* hbuf = (bf16*)(ws + WS_H); bf16* ma = (bf16*)(ws + WS_MA);

    for (int u = tid; u < (LDS_BYTES - LDSCTL_OFF) / 4; u += NWAVES * 64) ((LAS unsigned*)(lds + LDSCTL_OFF))[u] = 0u;
    __syncthreads();
    XcdBarrier bar; bar.bar = (unsigned*)(ctl + CW_BAR); bar.x = 0; bar.st = nullptr;
    if (N_LAUNCHES == 1) { bar = xcd_barrier_post((unsigned*)(ctl + CW_BAR), MISC + 8);
        if (tid == 0) (void)__hip_atomic_fetch_or((unsigned*)(ctl + CW_GRP + (bx & 7)), 1u << bar.x, RLX_AGENT); }
    const int lo = args.ph_lo, hi = args.ph_hi;
    if (N_LAUNCHES != 1) { __builtin_amdgcn_fence(__ATOMIC_RELEASE, "agent"); asm volatile("s_waitcnt vmcnt(0)" ::: "memory"); __builtin_amdgcn_fence(__ATOMIC_ACQUIRE, "agent"); asm volatile("s_waitcnt vmcnt(0)" ::: "memory"); __syncthreads(); }
#define IN(k) (lo <= (k) && (k) < hi)
#define SEAM(k) do { if (lo <= (k) && (k) + 1 < hi) xcd_barrier(bar); } while (0)
    bool fastb = false;
#define SEAML(k) do { if (lo <= (k) && (k) + 1 < hi) { if (fastb) xcd_barrier_local(bar); else xcd_barrier(bar); } } while (0)
    const int gw = vcu * NWAVES + wave, NGW = G * NWAVES, gtid = vcu * (NWAVES * 64) + tid, NGT = G * NWAVES * 64;

    if (IN(0)) {
        LAS float* ldsf = (LAS float*)lds;
        for (int blk = vcu; blk < 192; blk += G) {
            __syncthreads();
            const int col = tid & 15, ksl = tid >> 4, n = 16 * blk + col;
            float wv[32];
#pragma unroll
            for (int kk = 0; kk < 32; ++kk) wv[kk] = args.w_ada[(size_t)(ksl * 32 + kk) * 3072 + n];
            for (int i = tid; i < 8 * 1024; i += NWAVES * 64) ldsf[i] = siluf(args.c[i]);
            __syncthreads();
            float a[8];
#pragma unroll
            for (int b = 0; b < 8; ++b) a[b] = 0.f;
#pragma unroll
            for (int k4 = 0; k4 < 8; ++k4) {
#pragma unroll
                for (int b = 0; b < 8; ++b) { const f32x4 cv = *(const LAS f32x4*)(ldsf + b * 1024 + ksl * 32 + 4 * k4);
                    a[b] += (cv.x * wv[4 * k4] + cv.y * wv[4 * k4 + 1]) + (cv.z * wv[4 * k4 + 2] + cv.w * wv[4 * k4 + 3]); } }
            LAS float* red = ldsf + 8192;
#pragma unroll
            for (int b = 0; b < 8; ++b) red[(ksl * 8 + b) * 16 + col] = a[b];
            __syncthreads();
            if (tid < 128) { const int b = tid >> 4; float sacc = 0.f;
                for (int k2 = 0; k2 < 32; ++k2) sacc += red[(k2 * 8 + b) * 16 + col];
                ada[b * 3072 + n] = sacc + args.b_ada[n]; }
        }
        __syncthreads();
        LAS float* scr = (LAS float*)(lds + wave * 16384);
        constexpr int I_IN = 16 * (NIN / 32), I_A = 8 * 32, I_O = 16 * 32, NITEMS = I_IN + 2 * I_A + I_O;
        const bool p0bal = (G == 256); const int nslow = 192 * NWAVES, nfast = 64 * NWAVES;
        const int t_i0 = !p0bal ? gw : (gw < nslow ? gw : 2 * nslow + (gw - nslow)), t_st = !p0bal ? NGW : (gw < nslow ? nslow : nfast), t_end = !p0bal ? NITEMS : (gw < nslow ? 2 * nslow : NITEMS);
        for (int it = t_i0; it < t_end; it += t_st) {
            int r = it;
            if (r < I_IN) { const int kb = r / (NIN / 32), nb = r % (NIN / 32); const int np_ = 32 * nb, pn_ = tile_lt(np_ >> 8); transpose_item(args.w_in, 1024, NIN, win_t, win_srccol(np_), np_, 64 * kb, scr, lane, pn_ < 18 && ((pn_ % 6) >> 1) < 2 && ((np_ & 255) >> 7) == 0); continue; } r -= I_IN;
            if (r < I_A) { transpose_item(args.wa, 512, 1024, wa_t, 32 * (r % 32), 32 * (r % 32), 64 * (r / 32), scr, lane); continue; } r -= I_A;
            if (r < I_A) { transpose_item(args.wb, 512, 1024, wb_t, 32 * (r % 32), 32 * (r % 32), 64 * (r / 32), scr, lane); continue; } r -= I_A;
            transpose_item(args.wout, 1024, 1024, wout_t, 32 * (r % 32), 32 * (r % 32), 64 * (r / 32), scr, lane);
        }
        for (int i = gtid; i < 8 * 128 * 128 / 8; i += NGT) {
            const int e0 = i * 8, t = (e0 >> 7) & 127, s0 = e0 & 127; const f32x4 w0 = *(const f32x4*)(args.wsp + e0), w1 = *(const f32x4*)(args.wsp + e0 + 4);
            float v[8] = {w0[0], w0[1], w0[2], w0[3], w1[0], w1[1], w1[2], w1[3]};
#pragma unroll
            for (int j = 0; j < 8; ++j) v[j] = (s0 + j <= t) ? v[j] : 0.f;
            v4u o; o.x = pk2(v[0], v[1]); o.y = pk2(v[2], v[3]); o.z = pk2(v[4], v[5]); o.w = pk2(v[6], v[7]);
            *(v4u*)(wspb + e0) = o;
        }
        for (int i = gtid; i < MTOK * 8; i += NGT) {
            const int tok = i >> 3, fi = i & 7; const float freq = exp2f(-(float)fi * (18.931568569324174f / 8.f));
            const float ang = (float)args.pos[tok] * freq;
            const double ad = (double)ang; const double nrev = rint(ad * 0.15915494309189535); const float rr = (float)(ad - nrev * 6.283185307179586);
            rope[tok * 16 + fi] = cosf(rr); rope[tok * 16 + 8 + fi] = sinf(rr);
        }
        if (gtid < 3) { float mq = 0.f, mk = 0.f; for (int d = 0; d < 64; ++d) { mq = fmaxf(mq, fabsf(args.qg[gtid * 64 + d])); mk = fmaxf(mk, fabsf(args.kg[gtid * 64 + d])); }
            ref2tab[gtid] = 8.f * mq * mk * LOG2E * 1.03f + 0.25f; }
    }
    SEAM(0);
    if (N_LAUNCHES == 1 && G == 256) {
        if (tid == 0) { unsigned ok = 1u;
            for (int x = 0; x < 8; ++x) { const unsigned m = xb_ld((unsigned*)(ctl + CW_GRP + x)); ok &= (__builtin_popcount(m) == 1) ? 1u : 0u; }
            MISC[12] = ok; }
        __syncthreads();
        fastb = __builtin_amdgcn_readfirstlane((int)MISC[12]) != 0;
    }
    if (IN(1)) {
        for (int m0 = gw * 8; m0 < MTOK; m0 += NGW * 8) {
            const int b = m0 >> 11; f32x4 gm[4], sh[4], cur[4], nxt[4];
#pragma unroll
            for (int j = 0; j < 4; ++j) { const int k0 = 256 * j + 4 * lane;
                gm[j] = *(const f32x4*)(args.norm_g + k0) * (*(const f32x4*)(ada + b * 3072 + 1024 + k0) + 1.f); sh[j] = *(const f32x4*)(ada + b * 3072 + k0);
                cur[j] = ((const GAS f32x4*)(args.x + (size_t)m0 * DM) + lane)[64 * j]; }
#pragma unroll
            for (int r = 0; r < 8; ++r) {
                if (r < 7) {
#pragma unroll
                    for (int j = 0; j < 4; ++j) nxt[j] = ((const GAS f32x4*)(args.x + (size_t)(m0 + r + 1) * DM) + lane)[64 * j]; }
                float ss = 0.f;
#pragma unroll
                for (int j = 0; j < 4; ++j) ss += (cur[j].x * cur[j].x + cur[j].y * cur[j].y) + (cur[j].z * cur[j].z + cur[j].w * cur[j].w);
                const float rstd = __builtin_amdgcn_rsqf(wave_sum(ss) * (1.f / DM) + EPSN);
                GAS unsigned long long* o8 = (GAS unsigned long long*)(hbuf + (size_t)(m0 + r) * DM) + lane;
#pragma unroll
                for (int j = 0; j < 4; ++j) { const f32x4 hv = (cur[j] * rstd) * gm[j] + sh[j];
                    o8[64 * j] = (unsigned long long)pk2(hv.x, hv.y) | ((unsigned long long)pk2(hv.z, hv.w) << 32); }
#pragma unroll
                for (int j = 0; j < 4; ++j) cur[j] = nxt[j];
            }
        }
    }
    SEAML(1);
    const bool split9 = (G == 256); const bool late = split9 && bx < 128;
    const bool hook = late && fastb;
    if (IN(2)) {
        pg8::Gemm g{hbuf, win_t, MTOK, NZ2, DM}; RangeOrder S; S.S.init(MTOK, NZ2, G, bx); S.i0 = 0; S.n = split9 ? (hook ? 7 : 6) : 1 << 20;
        if (hook) { S.hook_after = 6; S.hb = bar; S.wcnt = MISC + 13; }
        if (split9) {
            pg8::Unit u0; S.next(0, u0);
            LAS f32x4* lr4 = (LAS f32x4*)(lds + LDS_ROPE); const f32x4* gr4 = (const f32x4*)(rope + (size_t)u0.pm * 256 * 16);
            for (int i = tid; i < 256 * 16 / 4; i += NWAVES * 64) lr4[i] = gr4[i];
            if (tid < 96) { const int e = tid * 4, gg = e >> 7, tt = (e >> 6) & 1, d = e & 63; ((LAS f32x4*)(lds + LDS_GAIN))[tid] = *(const f32x4*)((tt == 0 ? args.qg : args.kg) + gg * 64 + d); }
            LDS_WAIT(); __syncthreads();
            EpiZT<true> E{qkv, ga, ug, vg, ma, mb, stats, rope, args.qg, args.kg, (const LAS float*)(lds + LDS_ROPE), (const LAS float*)(lds + LDS_GAIN)};
            pg8::gemm_phase<EpiZT<true>, RangeOrder, true, true>(lds, g, S, E);
        } else {
            EpiZ E{qkv, ga, ug, vg, ma, mb, stats, rope, args.qg, args.kg};
            pg8::gemm_phase<EpiZ, RangeOrder, true, true>(lds, g, S, E);
        }
    }
    if (hook) { if (lo <= 2 && 3 < hi) xcd_local_wait(bar); } else SEAML(2);
    if (IN(3)) {
        if (late && !hook) {
            pg8::Gemm g{hbuf, win_t, MTOK, NZ2, DM}; RangeOrder S; S.S.init(MTOK, NZ2, G, bx); S.i0 = 6; S.n = 1;
            EpiZ E{qkv, ga, ug, vg, ma, mb, stats, rope, args.qg, args.kg};
            pg8::gemm_phase<EpiZ, RangeOrder, true, true>(lds, g, S, E);
        }
        if (split9) {
            const int grp = vcu >> 5, j = vcu & 31;
            const int a0 = grp * 384 + (j < 16 ? 9 * j : 144 + 15 * (j - 16)), cnt = j < 16 ? 9 : 15;
            att2::attn_phase(a0, cnt, qkv, lse, ref2tab, lds);
            const int i0 = grp * 128 + (j < 16 ? 3 * j : 48 + 5 * (j - 16)), ni = j < 16 ? 3 : 5;
            int i = 0;
            for (; i + 1 < ni; i += 2) gmlp_items2(i0 + i, i0 + i + 1, vg, ug, stats, wspb, args.bsp, args.lng, args.lnb, lds);
            if (i < ni) gmlp_item(i0 + i, vg, ug, stats, wspb, args.bsp, args.lng, args.lnb, lds);
        } else {
            const int per = (att2::NITEM + G - 1) / G, a0 = vcu * per, cnt = (att2::NITEM - a0) < per ? (att2::NITEM - a0) : per;
            att2::attn_phase(a0, cnt, qkv, lse, ref2tab, lds);
            int i = vcu;
            for (; i + G < 8 * 16 * 8; i += 2 * G) gmlp_items2(i, i + G, vg, ug, stats, wspb, args.bsp, args.lng, args.lnb, lds);
            if (i < 8 * 16 * 8) gmlp_item(i, vg, ug, stats, wspb, args.bsp, args.lng, args.lnb, lds);
        }
    }
    SEAML(3);
    if (IN(4)) {
#define P4_LOAD(IT, LS, OV, GV) do { const int tok_ = (IT) >> 6, h_ = ((IT) >> 3) & 7, j_ = (IT) & 7, b_ = tok_ >> 11, s_ = tok_ & 2047; \
            _Pragma("unroll") for (int g = 0; g < 3; ++g) { const int dsh = 2 * g, sp = ((s_ & ((1 << dsh) - 1)) << (11 - dsh)) + (s_ >> dsh); \
                LS[g] = lse[((size_t)(g * 8 + b_) * 8 + h_) * 2048 + sp]; \
                OV[g] = *(const v4u*)(qkv + ((size_t)(((b_ * 3 + g) * 3) * 8 + h_) * 2048 + sp) * 64 + j_ * 8); } \
            GV = *(const v4u*)(ga + (size_t)tok_ * 512 + h_ * 64 + j_ * 8); } while (0)
        constexpr int NIT4 = MTOK * 64;
        const int p4_i0 = split9 ? (vcu >> 5) * (2048 * 64) + (vcu & 31) * (NWAVES * 64) + tid : gtid, p4_st = split9 ? 32 * NWAVES * 64 : NGT, p4_end = split9 ? ((vcu >> 5) + 1) * (2048 * 64) : NIT4;
        float lsA[3], lsB[3], lsC[3]; v4u ovA[3], ovB[3], ovC[3]; v4u gvA, gvB, gvC;
#define CMB(f, OV, GV) { const float a0 = (w0 * bflo(OV[0].f) + w1 * bflo(OV[1].f)) + w2 * bflo(OV[2].f), a1 = (w0 * bfhi(OV[0].f) + w1 * bfhi(OV[1].f)) + w2 * bfhi(OV[2].f); o.f = pg8::cvt_pk_bf16(a0 * bflo(GV.f), a1 * bfhi(GV.f)); }
#define P4_STEP(IT, LS, OV, GV, LSN, OVN, GVN) do { const int it_ = (IT); \
            { const int itn_ = it_ + 2 * p4_st < p4_end ? it_ + 2 * p4_st : p4_end - 1; P4_LOAD(itn_, LSN, OVN, GVN); }     \
            const int tok = it_ >> 6, h = (it_ >> 3) & 7, j = it_ & 7; \
            const float mx = fmaxf(fmaxf(LS[0], LS[1]), LS[2]); \
            float w0 = __builtin_amdgcn_exp2f((LS[0] - mx) * LOG2E), w1 = __builtin_amdgcn_exp2f((LS[1] - mx) * LOG2E), w2 = __builtin_amdgcn_exp2f((LS[2] - mx) * LOG2E); \
            const float inv = __builtin_amdgcn_rcpf(w0 + w1 + w2); w0 *= inv; w1 *= inv; w2 *= inv; \
            v4u o; CMB(x, OV, GV) CMB(y, OV, GV) CMB(z, OV, GV) CMB(w, OV, GV) \
            asm volatile("" ::: "memory"); \
            if (it_ < p4_end) *(v4u*)(ga + (size_t)tok * 512 + h * 64 + j * 8) = o; } while (0)
        { const int i0_ = p4_i0 < p4_end ? p4_i0 : p4_end - 1, i1_ = p4_i0 + p4_st < p4_end ? p4_i0 + p4_st : p4_end - 1; P4_LOAD(i0_, lsA, ovA, gvA); P4_LOAD(i1_, lsB, ovB, gvB); }
        for (int it = p4_i0; it < p4_end; it += 3 * p4_st) {
            P4_STEP(it, lsA, ovA, gvA, lsC, ovC, gvC);
            P4_STEP(it + p4_st, lsB, ovB, gvB, lsA, ovA, gvA);
            P4_STEP(it + 2 * p4_st, lsC, ovC, gvC, lsB, ovB, gvB);
        }
#undef P4_STEP
#undef CMB
#undef P4_LOAD
    }
    SEAML(4);
    if (IN(5)) {
        { pg8::Gemm gz{hbuf, win_t, MTOK, NIN, DM}; MergeOrder Sz{G, bx};
          EpiZ Ez{qkv, ga, ug, vg, ma, mb, stats, rope, args.qg, args.kg};
          pg8::gemm_phase<EpiZ, MergeOrder, true, true>(lds, gz, Sz, Ez); }
        pg8::Gemm g{ga, wa_t, 2 * MTOK, 2048, 512}; PairOrder S{G, bx};
        EpiMrg E{ma, mb, merged};
        pg8::gemm_phase<EpiMrg, PairOrder, true, true>(lds, g, S, E);
    }
    SEAML(5);
    if (IN(6)) {
        pg8::Gemm g{merged, wout_t, MTOK, DM, DM, (OVL_BSTR - (size_t)2048 * 1024) * 2}; pg8::StaticOrder S; S.init(MTOK, DM, G, bx);
        EpiOut E{args.x, ada, args.out};
        pg8::gemm_phase<EpiOut, pg8::StaticOrder, true, true>(lds, g, S, E);
    }

    if (N_LAUNCHES != 1) { asm volatile("s_waitcnt vmcnt(0)" ::: "memory"); __builtin_amdgcn_fence(__ATOMIC_RELEASE, "agent"); asm volatile("s_waitcnt vmcnt(0)" ::: "memory"); }
#undef IN
#undef SEAM
#undef SEAML
}

extern "C" void kernel_launch(void* const* d_in, const int* in_sizes, int n_in, void* d_out, int out_size, void* d_ws, size_t ws_size, hipStream_t stream) {
    static int grid = 0;
    if (grid == 0) {
        if (n_in != 16 || in_sizes[0] != MTOK * DM || out_size != MTOK * DM || ws_size < WS_END) { fprintf(stderr, "kernel_launch: unexpected shapes (n_in %d, in0 %d, out %d, ws %zu); nothing launched\n", n_in, n_in > 0 ? in_sizes[0] : -1, out_size, ws_size); grid = -1; return; }
        int dev = 0, cus = 0, per_cu = 0;
        if (hipGetDevice(&dev) != hipSuccess || hipDeviceGetAttribute(&cus, hipDeviceAttributeMultiprocessorCount, dev) != hipSuccess) { fprintf(stderr, "kernel_launch: device query failed\n"); grid = -1; return; }
        if (hipFuncSetAttribute((const void*)fwd_kernel, hipFuncAttributeMaxDynamicSharedMemorySize, LDS_BYTES) != hipSuccess) { fprintf(stderr, "kernel_launch: hipFuncSetAttribute failed\n"); grid = -1; return; }
        if (hipOccupancyMaxActiveBlocksPerMultiprocessor(&per_cu, (const void*)fwd_kernel, NWAVES * 64, LDS_BYTES) != hipSuccess || per_cu < 1) { fprintf(stderr, "kernel_launch: occupancy query says %d workgroups per CU\n", per_cu); per_cu = 1; }
        (void)hipGetLastError();
        grid = cus;
    }
    if (grid < 0) return;
    if (hipMemsetAsync((char*)d_ws + WS_CTL, 0, CTL_ZERO_BYTES, stream) != hipSuccess) { fprintf(stderr, "kernel_launch: memset failed\n"); return; }
    Args a{};
    a.x = (const float*)d_in[0]; a.c = (const float*)d_in[1]; a.pos = (const int*)d_in[2]; a.norm_g = (const float*)d_in[3]; a.w_ada = (const float*)d_in[4]; a.b_ada = (const float*)d_in[5];
    a.w_in = (const float*)d_in[6]; a.qg = (const float*)d_in[7]; a.kg = (const float*)d_in[8]; a.lng = (const float*)d_in[9]; a.lnb = (const float*)d_in[10]; a.wsp = (const float*)d_in[11];
    a.bsp = (const float*)d_in[12]; a.wa = (const float*)d_in[13]; a.wb = (const float*)d_in[14]; a.wout = (const float*)d_in[15];
    a.out = (float*)d_out; a.ws = (unsigned char*)d_ws;
    const int nl = N_LAUNCHES;
    for (int li = 0; li < nl; ++li) {
        a.ph_lo = (N_LAUNCHES == 1) ? 0 : li; a.ph_hi = (N_LAUNCHES == 1) ? N_PHASES : li + 1; a.li = li;
        hipLaunchKernelGGL(fwd_kernel, dim3(grid), dim3(NWAVES * 64), LDS_BYTES, stream, a);
        const hipError_t le = hipPeekAtLastError();
        if (le != hipSuccess) { fprintf(stderr, "kernel_launch: launch %d failed: %s\n", li, hipGetErrorName(le)); break; }
    }
}
```

```cpp
#include <hip/hip_runtime.h>
#include <cstdio>
#include <cstdint>
#include <cmath>
namespace pg8 {
#define PG8_LAS __attribute__((address_space(3)))
typedef unsigned short bf16_t;
typedef short bf16x8 __attribute__((ext_vector_type(8)));
typedef float f32x4 __attribute__((ext_vector_type(4)));
typedef unsigned u32x4 __attribute__((ext_vector_type(4)));
constexpr int BM = 256, BK = 64, HALF = 128, HTB = HALF * BK * 2  , STAGE_BYTES = 8 * HTB, NXCD = 8, WGM = 8;

__host__ __device__ __forceinline__ int lds_byte(int r, int c) { const int st = (r >> 4) * 2 + (c >> 5), rr = r & 15, cc = c & 31, ob = rr * 64 + cc * 2; return st * 1024 + (ob ^ (((ob >> 9) & 1) << 5)); }
__host__ __device__ __forceinline__ void stage_rc(int b, int& R, int& C) { const int st = b / 1024, sb = b % 1024, swz = sb ^ (((sb >> 9) & 1) << 5); R = (st >> 1) * 16 + swz / 64; C = (st & 1) * 32 + (swz % 64) / 2; }
__host__ __device__ __forceinline__ int perm32(int rho) { const int n = rho >> 4, i = rho & 15; return 8 * (i >> 2) + 4 * n + (i & 3); }

struct Unit { int pm, pn; };
struct Gemm { const bf16_t* A; const bf16_t* Bt; int M, N, K; size_t abskip = 0; };

struct StaticOrder {
    int nM, nN, nwg, G, c;
    __host__ __device__ void init(int M, int N, int G_, int c_) { nM = M / BM; nN = N / BM; nwg = nM * nN; G = G_; c = c_; }
    __host__ __device__ bool next(int i, Unit& u) const {
        const long L = (long)i * G + c; if (L >= nwg) return false;
        int wgid = (int)L; { const int q = nwg / NXCD, r = nwg % NXCD, xcd = wgid % NXCD, off = wgid / NXCD; wgid = (xcd < r ? xcd * (q + 1) : r * (q + 1) + (xcd - r) * q) + off; }
        const int nig = WGM * nN, gid = wgid / nig, fm = gid * WGM, gsz = (nM - fm) < WGM ? (nM - fm) : WGM;
        u.pm = fm + ((wgid % nig) % gsz); u.pn = (wgid % nig) / gsz; return true;
    }
    __device__ __forceinline__ void a_ready(const Unit&) const {}
    __device__ __forceinline__ void done(const Unit&) const {}
};

typedef float cvt_f32x2_t __attribute__((ext_vector_type(2))); typedef __bf16 cvt_bf16x2_t __attribute__((ext_vector_type(2)));
__device__ __forceinline__ unsigned cvt_pk_bf16(float lo, float hi) { const cvt_f32x2_t v = {lo, hi}; const cvt_bf16x2_t b = __builtin_convertvector(v, cvt_bf16x2_t); return __builtin_bit_cast(unsigned, b); }
typedef float f32x2 __attribute__((ext_vector_type(2)));
__device__ __forceinline__ f32x2 gelu_pk(f32x2 v) {
    const f32x2 av = __builtin_elementwise_abs(v), d = av * 0.2316418882f + 1.0f;
    f32x2 t; t.x = __builtin_amdgcn_rcpf(d.x); t.y = __builtin_amdgcn_rcpf(d.y);
    f32x2 q = t * 0.5307027145f + (-0.7265760135f); q = q * t + 0.7107068705f; q = q * t + (-0.142248368f); q = q * t + 0.127414796f; q = q * t;
    const f32x2 s = (v * v) * (-0.72134752044f);
    f32x2 e; e.x = __builtin_amdgcn_exp2f(s.x); e.y = __builtin_amdgcn_exp2f(s.y);
    const f32x2 m = v * (q * e), r = v - m;
    f32x2 o; o.x = v.x < 0.f ? m.x : r.x; o.y = v.y < 0.f ? m.y : r.y; return o;
}
template <int ACT  > struct EpiBf16 {
    static constexpr bool PERM = true, AFTER_DRAIN = false, CARRY = false; static_assert(ACT == 0 || ACT == 1, "EpiBf16: ACT is 0 (none) or 1 (gelu_pk)");
    bf16_t* O; int ldc; const float* bias; int split_cols; size_t split_stride; float scale0;
    __device__ __forceinline__ void operator()(const f32x4 (&acc)[2][2][4][2], const Unit& u, int wr, int wc, int fr, int fq) const {
        const int row0 = u.pm * BM + wr * 64 + fr; int colt = u.pn * BM; bf16_t* base = O;
        float sc = 1.f; if (split_cols) { const int t = colt / split_cols; base += (size_t)t * split_stride; colt -= t * split_cols; if (t == 0) sc = scale0; }
        const int col0 = colt + wc * 32 + 8 * fq, bcol0 = u.pn * BM + wc * 32 + 8 * fq;
        f32x4 bv[2][2];
#pragma unroll
        for (int bj = 0; bj < 2; ++bj)
#pragma unroll
            for (int n = 0; n < 2; ++n) bv[bj][n] = bias ? *(const f32x4*)(bias + bcol0 + bj * HALF + 4 * n) : (f32x4){0.f, 0.f, 0.f, 0.f};
#pragma unroll
        for (int ai = 0; ai < 2; ++ai)
#pragma unroll
            for (int m = 0; m < 4; ++m) { bf16_t* rowp = base + (size_t)(row0 + ai * HALF + m * 16) * ldc + col0;
#pragma unroll
                for (int bj = 0; bj < 2; ++bj) { f32x4 v0 = acc[ai][bj][m][0] + bv[bj][0], v1 = acc[ai][bj][m][1] + bv[bj][1];
                    if (ACT == 1) { f32x2 a = gelu_pk((f32x2){v0[0], v0[1]}), b = gelu_pk((f32x2){v0[2], v0[3]}), c = gelu_pk((f32x2){v1[0], v1[1]}), d = gelu_pk((f32x2){v1[2], v1[3]});
                        v0 = (f32x4){a.x, a.y, b.x, b.y}; v1 = (f32x4){c.x, c.y, d.x, d.y}; }
                    v0 = v0 * sc; v1 = v1 * sc; u32x4 w; w.x = cvt_pk_bf16(v0[0], v0[1]); w.y = cvt_pk_bf16(v0[2], v0[3]); w.z = cvt_pk_bf16(v1[0], v1[1]); w.w = cvt_pk_bf16(v1[2], v1[3]);
                    *(u32x4*)(rowp + bj * HALF) = w; } }
    }
};

template <class Epi, class Sched, bool ALIGN_EPI = false, bool SP2 = false>
__device__ __forceinline__ void gemm_phase(PG8_LAS unsigned char* lds, const Gemm g, const Sched& S, const Epi& E) {
    const int tid = threadIdx.x, wid = __builtin_amdgcn_readfirstlane(tid >> 6), lane = tid & 63, wr = wid >> 2, wc = wid & 3, fr = lane & 15, fq = lane >> 4;
    const int K = g.K, nt = K / BK;
    unsigned voffA[2], voffB[2];
#pragma unroll
    for (int i = 0; i < 2; ++i) { int R, C; stage_rc(tid * 16 + i * 8192, R, C); const int Rb = Epi::PERM ? ((R & ~31) + perm32(R & 31)) : R;
        voffA[i] = (unsigned)(R * K + C) * 2u; voffB[i] = (unsigned)(Rb * K + C) * 2u; }
    const size_t kstep = (size_t)(BK * 2);
    const size_t hstep = (size_t)HALF * K * 2;
    const size_t tstep = 2 * hstep;
    const unsigned ldsw = (unsigned)wid * 1024u;
    const int aoff = lds_byte(wr * 64 + fr, fq * 8), boff = lds_byte(wc * 32 + fr, fq * 8);
#define PG8_SA(b, h) (((b) * 2 + (h)) * HTB)
#define PG8_SB(b, h) ((4 + (b) * 2 + (h)) * HTB)
#define PG8_STAGE(bufoff, gbase, voff) do { _Pragma("unroll") for (int _i = 0; _i < 2; ++_i) \
        __builtin_amdgcn_global_load_lds((const unsigned*)((const char*)(gbase) + (voff)[_i]), (PG8_LAS unsigned*)(lds + (bufoff) + ldsw + _i * 8192), 16, 0, 0); } while (0)
#define PG8_LDA(dst, b, h) do { _Pragma("unroll") for (int m = 0; m < 4; ++m) _Pragma("unroll") for (int k = 0; k < 2; ++k) dst[m][k] = *(const PG8_LAS bf16x8*)(lds + PG8_SA(b, h) + aoff + m * 2048 + k * 1024); } while (0)
#define PG8_LDB(dst, b, h) do { _Pragma("unroll") for (int n = 0; n < 2; ++n) _Pragma("unroll") for (int k = 0; k < 2; ++k) dst[n][k] = *(const PG8_LAS bf16x8*)(lds + PG8_SB(b, h) + boff + n * 2048 + k * 1024); } while (0)
#define PG8_MMA(ai, bj, At, Bt) do { __builtin_amdgcn_s_setprio(1); _Pragma("unroll") for (int m = 0; m < 4; ++m) _Pragma("unroll") for (int n = 0; n < 2; ++n) _Pragma("unroll") for (int k = 0; k < 2; ++k) \
        acc[ai][bj][m][n] = __builtin_amdgcn_mfma_f32_16x16x32_bf16(Bt[n][k], At[m][k], acc[ai][bj][m][n], 0, 0, 0); __builtin_amdgcn_s_setprio(0); } while (0)
#define PG8_WAIT_V(n) asm volatile("s_waitcnt vmcnt(" #n ")" ::: "memory")
#define PG8_WAIT_L(n) asm volatile("s_waitcnt lgkmcnt(" #n ")" ::: "memory")
#define PG8_BAR __builtin_amdgcn_s_barrier()
#define PG8_SCHED __builtin_amdgcn_sched_barrier(0)
    Unit cur, nxt; int ui = 0;
    if (!S.next(0, cur)) return;
    f32x4 acc[2][2][4][2];
#pragma unroll
    for (int a = 0; a < 2; ++a)
#pragma unroll
        for (int b = 0; b < 2; ++b)
#pragma unroll
            for (int m = 0; m < 4; ++m)
#pragma unroll
                for (int n = 0; n < 2; ++n) acc[a][b][m][n] = (f32x4){0.f, 0.f, 0.f, 0.f};
    bf16x8 At[4][2], B0[2][2], B1[2][2];
    const char* cA = (const char*)g.A + (size_t)cur.pm * tstep + (size_t)(cur.pm >> 3) * g.abskip; const char* cB = (const char*)g.Bt + (size_t)cur.pn * tstep;
    S.a_ready(cur);
    if constexpr (SP2) {
        PG8_STAGE(PG8_SB(0, 0), cB, voffB); PG8_STAGE(PG8_SB(0, 1), cB + hstep, voffB); PG8_STAGE(PG8_SA(0, 0), cA, voffA); PG8_STAGE(PG8_SA(0, 1), cA + hstep, voffA);
        if (wr == 1) PG8_BAR;
        PG8_WAIT_V(2); PG8_BAR;
        PG8_STAGE(PG8_SB(1, 0), cB + kstep, voffB); PG8_STAGE(PG8_SA(1, 0), cA + kstep, voffA); PG8_STAGE(PG8_SB(1, 1), cB + hstep + kstep, voffB);
        PG8_WAIT_V(6); PG8_BAR;
    } else {
        PG8_STAGE(PG8_SB(0, 0), cB, voffB); PG8_STAGE(PG8_SA(0, 0), cA, voffA); PG8_STAGE(PG8_SB(0, 1), cB + hstep, voffB); PG8_STAGE(PG8_SA(0, 1), cA + hstep, voffA);
        if (wr == 1) PG8_BAR;
        PG8_WAIT_V(4); PG8_BAR;
        PG8_STAGE(PG8_SB(1, 0), cB + kstep, voffB); PG8_STAGE(PG8_SA(1, 0), cA + kstep, voffA); PG8_STAGE(PG8_SB(1, 1), cB + hstep + kstep, voffB);
        PG8_WAIT_V(6); PG8_BAR;
    }
    for (;;) {
        const bool has_next = S.next(ui + 1, nxt);
        const char* nA = has_next ? (const char*)g.A + (size_t)nxt.pm * tstep + (size_t)(nxt.pm >> 3) * g.abskip : cA; const char* nB = has_next ? (const char*)g.Bt + (size_t)nxt.pn * tstep : cB;
        for (int t = 0; t < nt; t += 2) {
            const bool last = (t == nt - 2);
            const char* a1 = cA + (size_t)(t + 1) * kstep;
            const char* a2 = last ? nA : cA + (size_t)(t + 2) * kstep; const char* b2 = last ? nB : cB + (size_t)(t + 2) * kstep;
            const char* a3 = a2 + kstep; const char* b3 = b2 + kstep;
            if (last && has_next) S.a_ready(nxt);
            if constexpr (SP2) {
            PG8_LDB(B0, 0, 0); PG8_LDB(B1, 0, 1); PG8_SCHED; PG8_LDA(At, 0, 0); PG8_STAGE(PG8_SA(1, 1), a1 + hstep, voffA);
            PG8_WAIT_V(8); PG8_WAIT_L(0); PG8_BAR; PG8_MMA(0, 0, At, B0); PG8_MMA(0, 1, At, B1); PG8_BAR; PG8_SCHED;
            PG8_LDA(At, 0, 1); PG8_STAGE(PG8_SB(0, 0), b2, voffB); PG8_STAGE(PG8_SB(0, 1), b2 + hstep, voffB); PG8_STAGE(PG8_SA(0, 0), a2, voffA);
            PG8_WAIT_V(8); PG8_WAIT_L(0); PG8_BAR; PG8_MMA(1, 0, At, B0); PG8_MMA(1, 1, At, B1); PG8_BAR; PG8_SCHED;
            PG8_LDB(B0, 1, 0); PG8_LDB(B1, 1, 1); PG8_SCHED; PG8_LDA(At, 1, 0); PG8_STAGE(PG8_SA(0, 1), a2 + hstep, voffA);
            PG8_WAIT_V(8); PG8_WAIT_L(0); PG8_BAR; PG8_MMA(0, 0, At, B0); PG8_MMA(0, 1, At, B1); PG8_BAR; PG8_SCHED;
            PG8_LDA(At, 1, 1); PG8_STAGE(PG8_SB(1, 0), b3, voffB); PG8_STAGE(PG8_SB(1, 1), b3 + hstep, voffB); PG8_STAGE(PG8_SA(1, 0), a3, voffA);
            PG8_WAIT_V(8); PG8_WAIT_L(0); PG8_BAR; PG8_MMA(1, 0, At, B0); PG8_MMA(1, 1, At, B1); PG8_BAR; PG8_SCHED;
            } else {
            PG8_LDB(B0, 0, 0); PG8_SCHED; PG8_LDA(At, 0, 0); PG8_STAGE(PG8_SA(1, 1), a1 + hstep, voffA);
            PG8_WAIT_L(8); PG8_BAR; PG8_WAIT_L(0); PG8_MMA(0, 0, At, B0); PG8_BAR; PG8_SCHED;
            PG8_LDB(B1, 0, 1); PG8_STAGE(PG8_SB(0, 0), b2, voffB);
            PG8_BAR; PG8_WAIT_L(0); PG8_MMA(0, 1, At, B1); PG8_BAR;
            PG8_LDA(At, 0, 1); PG8_STAGE(PG8_SA(0, 0), a2, voffA);
            PG8_BAR; PG8_WAIT_L(0); PG8_MMA(1, 0, At, B0); PG8_BAR; PG8_SCHED;
            PG8_STAGE(PG8_SB(0, 1), b2 + hstep, voffB);
            PG8_WAIT_V(6); PG8_BAR; PG8_MMA(1, 1, At, B1); PG8_BAR;
            PG8_LDB(B0, 1, 0); PG8_SCHED; PG8_LDA(At, 1, 0); PG8_STAGE(PG8_SA(0, 1), a2 + hstep, voffA);
            PG8_WAIT_L(8); PG8_BAR; PG8_WAIT_L(0); PG8_MMA(0, 0, At, B0); PG8_BAR; PG8_SCHED;
            PG8_LDB(B1, 1, 1); PG8_STAGE(PG8_SB(1, 0), b3, voffB);
            PG8_BAR; PG8_WAIT_L(0); PG8_MMA(0, 1, At, B1); PG8_BAR;
            PG8_LDA(At, 1, 1); PG8_STAGE(PG8_SA(1, 0), a3, voffA);
            PG8_BAR; PG8_WAIT_L(0); PG8_MMA(1, 0, At, B0); PG8_BAR; PG8_SCHED;
            PG8_STAGE(PG8_SB(1, 1), b3 + hstep, voffB);
            PG8_WAIT_V(6); PG8_BAR; PG8_MMA(1, 1, At, B1); PG8_BAR;
            }
        }
        if constexpr (ALIGN_EPI) { if (wr == 0) PG8_BAR; }
        if constexpr (!Epi::AFTER_DRAIN) { E(acc, cur, wr, wc, fr, fq); S.done(cur); }
        if (!has_next) break;
        bool carry_ = false; if constexpr (Epi::CARRY) carry_ = E.carry(cur);
        if (!carry_) {
#pragma unroll
        for (int a = 0; a < 2; ++a)
#pragma unroll
            for (int b = 0; b < 2; ++b)
#pragma unroll
                for (int m = 0; m < 4; ++m)
#pragma unroll
                    for (int n = 0; n < 2; ++n) acc[a][b][m][n] = (f32x4){0.f, 0.f, 0.f, 0.f};
        }
        cur = nxt; cA = nA; cB = nB; ++ui;
        if constexpr (ALIGN_EPI) { if (wr == 1) PG8_BAR; }
    }
    PG8_WAIT_V(0);
    if constexpr (!ALIGN_EPI) { if (wr == 0) PG8_BAR; }
    PG8_BAR;
    if constexpr (Epi::AFTER_DRAIN) { E.fused(acc, cur, wr, wc, fr, fq, lds, wid, lane); S.done(cur); }
#undef PG8_SA
#undef PG8_SB
#undef PG8_STAGE
#undef PG8_LDA
#undef PG8_LDB
#undef PG8_MMA
#undef PG8_WAIT_V
#undef PG8_WAIT_L
#undef PG8_BAR
#undef PG8_SCHED
}
}
#define GAS __attribute__((address_space(1)))
#define LAS __attribute__((address_space(3)))
typedef unsigned short bf16;
typedef unsigned v4u __attribute__((ext_vector_type(4)));
typedef float f32x4 __attribute__((ext_vector_type(4)));
typedef short bf16x8 __attribute__((ext_vector_type(8)));
typedef GAS unsigned gu32;
typedef GAS unsigned long long gu64;
#define RLX_AGENT __ATOMIC_RELAXED, __HIP_MEMORY_SCOPE_AGENT
#define LDS_WAIT() asm volatile("s_waitcnt lgkmcnt(0)" ::: "memory")
#define VM_WAIT() asm volatile("s_waitcnt vmcnt(0)" ::: "memory")
__device__ __forceinline__ unsigned long long rt() { return __builtin_amdgcn_s_memrealtime(); }
__device__ __forceinline__ unsigned f2bf(float f) { unsigned u = __builtin_bit_cast(unsigned, f); return (u + 0x7fffu + ((u >> 16) & 1u)) >> 16; }
__device__ __forceinline__ unsigned pk2(float lo, float hi) { return f2bf(lo) | (f2bf(hi) << 16); }
#define XB_TMO      128
#define XB_XCNT(j)  (256  + 64 * (j))
#define XB_XSUB(j)  (1280 + 64 * (j))
#define XB_XGEN(j)  (2304 + 64 * (j))
#define XB_TOP      3328
#define XB_TOPGEN   3392
#define XCD_BAR_WORDS 3456
#define XB_SPIN_CAP (1u << 18)

__device__ __forceinline__ unsigned xb_ld(unsigned* p)              { return __hip_atomic_load(p, __ATOMIC_RELAXED, __HIP_MEMORY_SCOPE_AGENT); }
__device__ __forceinline__ unsigned xb_add(unsigned* p, unsigned v) { return __hip_atomic_fetch_add(p, v, __ATOMIC_RELAXED, __HIP_MEMORY_SCOPE_AGENT); }
__device__ __forceinline__ unsigned xb_xcc_id() { return (unsigned)__builtin_amdgcn_s_getreg((3 << 11) | 20) & 0xFu; }
#define XB_SPIN(cond, bar) do { unsigned _sp = 0; while (cond) { __builtin_amdgcn_s_sleep(1); \
    if ((++_sp & 255u) == 0u) { if (xb_ld(&(bar)[XB_TMO])) break; if (_sp > XB_SPIN_CAP) { atomicAdd(&(bar)[XB_TMO], 1u); break; } } } } while (0)

struct XcdBarrier {
    unsigned* bar; unsigned x;
    volatile LAS unsigned* st;
};

__device__ __forceinline__ XcdBarrier xcd_barrier_post(unsigned* bar, volatile LAS unsigned* st) {
    XcdBarrier b; b.bar = bar; b.x = xb_xcc_id(); b.st = st;
    if (threadIdx.x == 0) (void)xb_add(&bar[XB_XCNT(b.x)], 1u);
    return b;
}
__device__ __forceinline__ void xcd_barrier_complete(unsigned* bar, unsigned x, unsigned& nloc, unsigned& nx) {
    const unsigned G = gridDim.x * gridDim.y * gridDim.z;
    unsigned sum, cnt, mine, sp = 0u;
    for (;;) {
        sum = 0u; cnt = 0u; mine = 0u;
#pragma unroll
        for (unsigned j = 0; j < 16; ++j) { const unsigned c = xb_ld(&bar[XB_XCNT(j)]); sum += c; cnt += (c > 0u) ? 1u : 0u; mine = (j == x) ? c : mine; }
        if (sum == G) break;
        __builtin_amdgcn_s_sleep(1);
        if ((++sp & 255u) == 0u) { if (xb_ld(&bar[XB_TMO])) break; if (sp > XB_SPIN_CAP) { atomicAdd(&bar[XB_TMO], 1u); break; } }
    }
    nloc = mine > 0u ? mine : 1u; nx = cnt > 0u ? cnt : 1u;
}

__device__ __forceinline__ void xcd_barrier(const XcdBarrier& b) {
    asm volatile("s_waitcnt vmcnt(0)" ::: "memory");
    __syncthreads();
    if (threadIdx.x == 0) {
        unsigned* bar = b.bar;
        __builtin_amdgcn_s_waitcnt(0);
        unsigned nloc = b.st[0], nx = b.st[1];
        if (nloc == 0u) { xcd_barrier_complete(bar, b.x, nloc, nx); b.st[0] = nloc; b.st[1] = nx; }
        const unsigned old = xb_add(&bar[XB_XSUB(b.x)], 1u);
        const unsigned gen = old / nloc;
        if (old + 1u == (gen + 1u) * nloc) {
            __builtin_amdgcn_fence(__ATOMIC_RELEASE, "agent");
            asm volatile("s_waitcnt vmcnt(0)" ::: "memory");
            const unsigned og = xb_add(&bar[XB_TOP], 1u);
            const unsigned tg = og / nx;
            if (og + 1u == (tg + 1u) * nx) xb_add(&bar[XB_TOPGEN], 1u);
            else XB_SPIN(xb_ld(&bar[XB_TOPGEN]) == tg, bar);
            __builtin_amdgcn_fence(__ATOMIC_ACQUIRE, "agent");
            xb_add(&bar[XB_XGEN(b.x)], 1u);
            asm volatile("s_waitcnt vmcnt(0)" ::: "memory");
        } else {
            XB_SPIN(xb_ld(&bar[XB_XGEN(b.x)]) == gen, bar);
            __builtin_amdgcn_fence(__ATOMIC_ACQUIRE, "agent");
            asm volatile("s_waitcnt vmcnt(0)" ::: "memory");
        }
    }
    __syncthreads();
}

__device__ __forceinline__ void xcd_barrier_local(const XcdBarrier& b) {
    asm volatile("s_waitcnt vmcnt(0)" ::: "memory");
    __syncthreads();
    if (threadIdx.x == 0) {
        unsigned* bar = b.bar;
        __builtin_amdgcn_s_waitcnt(0);
        unsigned nloc = b.st[0]; if (nloc == 0u) nloc = 1u;
        asm volatile("buffer_inv sc1" ::: "memory");
        const unsigned old = xb_add(&bar[XB_XSUB(b.x)], 1u);
        const unsigned gen = old / nloc;
        if (old + 1u == (gen + 1u) * nloc) xb_add(&bar[XB_XGEN(b.x)], 1u);
        else XB_SPIN(xb_ld(&bar[XB_XGEN(b.x)]) == gen, bar);
        asm volatile("s_waitcnt vmcnt(0)" ::: "memory");
    }
    __syncthreads();
}

__device__ __forceinline__ void xcd_local_arrive(const XcdBarrier& b) {
    unsigned* bar = b.bar; unsigned nloc = b.st[0]; if (nloc == 0u) nloc = 1u;
    const unsigned old = xb_add(&bar[XB_XSUB(b.x)], 1u);
    const unsigned gen = old / nloc;
    if (old + 1u == (gen + 1u) * nloc) xb_add(&bar[XB_XGEN(b.x)], 1u);
    b.st[3] = gen + 1u;
}
__device__ __forceinline__ void xcd_local_wait(const XcdBarrier& b) {
    asm volatile("s_waitcnt vmcnt(0)" ::: "memory");
    __syncthreads();
    if (threadIdx.x == 0) {
        unsigned* bar = b.bar;
        __builtin_amdgcn_s_waitcnt(0);
        const unsigned gen = b.st[3] - 1u; b.st[3] = 0u;
        XB_SPIN(xb_ld(&bar[XB_XGEN(b.x)]) == gen, bar);
        __builtin_amdgcn_fence(__ATOMIC_ACQUIRE, "agent");
        asm volatile("s_waitcnt vmcnt(0)" ::: "memory");
    }
    __syncthreads();
}

constexpr int NWAVES = 8;
#define MK_N_LAUNCHES 1
#ifndef MK_N_LAUNCHES
#define MK_N_LAUNCHES 1
#endif
constexpr int N_PHASES = 7;
constexpr int NZ2 = 26 * 256;
constexpr int N_LAUNCHES = MK_N_LAUNCHES;
constexpr int BATCH = 8, SEQ = 2048, DM = 1024, MTOK = BATCH * SEQ, NIN = 8704;
constexpr float EPSN = 1e-6f, LOG2E = 1.4426950408889634f, LN2 = 0.6931471805599453f, QSCALE = 0.125f * 1.4426950408889634f;
constexpr size_t MiB = 1u << 20;
constexpr size_t WS_CTL = 0, CTL_ZERO_BYTES = 64 * 1024;
constexpr size_t WS_ADA = 1 * MiB;
constexpr size_t WS_MISC = 1 * MiB + 128 * 1024;
constexpr size_t WS_WSP = 1 * MiB + 256 * 1024;
constexpr size_t WS_LSE = 1 * MiB + 512 * 1024;
constexpr size_t WS_STATS = 3 * MiB;
constexpr size_t WS_ROPE = 4 * MiB;
constexpr size_t WS_WIN = 5 * MiB;
constexpr size_t WS_WA = 22 * MiB, WS_WB = 23 * MiB;
constexpr size_t WS_WOUT = 24 * MiB;
constexpr size_t WS_QKV = 26 * MiB;
constexpr size_t WS_GA = 170 * MiB;
constexpr size_t WS_UG = 186 * MiB;
constexpr size_t WS_VG = 202 * MiB;
constexpr size_t OVL_BSTR = 18 * MiB / 2;
constexpr size_t WS_MERGED = 26 * MiB;
constexpr size_t WS_MA = 26 * MiB + 4 * MiB;
constexpr size_t WS_MBO = 26 * MiB + 8 * MiB;
constexpr size_t WS_H = 218 * MiB;
__host__ __device__ __forceinline__ size_t ovl_row(int r) { return (size_t)(r >> 11) * OVL_BSTR + (size_t)(r & 2047) * 1024; }
constexpr size_t WS_END = 250 * MiB;
constexpr int CW_BAR = 4096, CW_GRP = 8192;
constexpr int LDSCTL_OFF = 149504, MISC_OFF = LDSCTL_OFF + 320, LDS_BYTES = 157696;
constexpr int LDS_ROPE = 131072, LDS_GAIN = LDS_ROPE + 256 * 16 * 4;

typedef float f32x2 __attribute__((ext_vector_type(2)));
typedef float f32x16 __attribute__((ext_vector_type(16)));
typedef short v4i16_t __attribute__((ext_vector_type(4)));
__device__ __forceinline__ float sigm(float x) { return __builtin_amdgcn_rcpf(1.f + __builtin_amdgcn_exp2f(-LOG2E * x)); }
__device__ __forceinline__ float siluf(float x) { return x * sigm(x); }
__device__ __forceinline__ float bflo(unsigned w) { return __builtin_bit_cast(float, w << 16); }
__device__ __forceinline__ float bfhi(unsigned w) { return __builtin_bit_cast(float, w & 0xffff0000u); }
__device__ __forceinline__ v4u pack8(f32x4 a, f32x4 b) { v4u w; w.x = pg8::cvt_pk_bf16(a[0], a[1]); w.y = pg8::cvt_pk_bf16(a[2], a[3]); w.z = pg8::cvt_pk_bf16(b[0], b[1]); w.w = pg8::cvt_pk_bf16(b[2], b[3]); return w; }
__device__ __forceinline__ f32x4 gelu4(f32x4 v) { const pg8::f32x2 a = pg8::gelu_pk((pg8::f32x2){v[0], v[1]}), b = pg8::gelu_pk((pg8::f32x2){v[2], v[3]}); return (f32x4){a.x, a.y, b.x, b.y}; }
__device__ __forceinline__ f32x4 silu4(f32x4 v) { return (f32x4){siluf(v[0]), siluf(v[1]), siluf(v[2]), siluf(v[3])}; }
__device__ __forceinline__ f32x4 sigm4(f32x4 v) { return (f32x4){sigm(v[0]), sigm(v[1]), sigm(v[2]), sigm(v[3])}; }

__host__ __device__ __forceinline__ int tile_lt(int pn) { return pn < 4 ? pn + 20 : pn < 6 ? pn + 20 : pn < 24 ? pn - 6 : pn < 26 ? pn - 6 : pn; }
__host__ __device__ __forceinline__ int win_srccol(int np) {
    const int pn = tile_lt(np >> 8), j = np & 255;
    if (pn < 18) { const int g = pn / 6, t = (pn % 6) >> 1, half = pn & 1; return g * 1536 + t * 512 + half * 256 + 64 * ((j & 127) >> 5) + 32 * (j >> 7) + (j & 31); }
    if (pn < 20) return 4608 + (pn - 18) * 256 + j;
    if (pn < 24) return (j < 128) ? 5120 + 128 * (pn - 20) + j : 6144 + 128 * (pn - 20) + (j - 128);
    if (pn < 26) return 5632 + (pn - 24) * 256 + j;
    return (j < 128) ? 6656 + 128 * (pn - 26) + j : 7680 + 128 * (pn - 26) + (j - 128);
}

template <bool LR  > struct EpiZT {
    static constexpr bool PERM = true, AFTER_DRAIN = false, CARRY = false;
    bf16* qkv; bf16* ga; bf16* ug; bf16* vg; bf16* ma; bf16* mb; float* stats; const float* rope; const float* qg; const float* kg; const LAS float* lrope = nullptr; const LAS float* lgain = nullptr;
    __device__ __forceinline__ void operator()(const pg8::f32x4 (&acc)[2][2][4][2], const pg8::Unit& u, int wr, int wc, int fr, int fq) const {
        const int pn = tile_lt(u.pn), row0 = u.pm * 256 + wr * 64 + fr;
        if (pn < 18) {
            const int g = pn / 6, t = (pn % 6) >> 1, head = (pn & 1) * 4 + wc, b = u.pm >> 3, dsh = 2 * g;
            bf16* base = qkv + (size_t)((((b * 3 + g) * 3 + t) * 8 + head) * 2048) * 64 + 8 * fq;
            if (t < 2) {
                const float* gbase = (t == 0 ? qg : kg) + g * 64; const float gs = (t == 0) ? QSCALE : 1.f; const bool lowq = fq < 2;
                f32x4 gn[2][2];
#pragma unroll
                for (int n = 0; n < 2; ++n) {
                    if constexpr (LR) { const LAS float* lg = lgain + (g * 2 + t) * 64; gn[0][n] = *(const LAS f32x4*)(lg + (lowq ? 8 * n + 4 * fq : 8 * fq + 4 * n)); gn[1][n] = *(const LAS f32x4*)(lg + 32 + 8 * fq + 4 * n); }
                    else { gn[0][n] = *(const f32x4*)(gbase + (lowq ? 8 * n + 4 * fq : 8 * fq + 4 * n)); gn[1][n] = *(const f32x4*)(gbase + 32 + 8 * fq + 4 * n); } }
                constexpr int RD = 3; f32x4 rc[RD], rsn[RD];
#pragma unroll
                for (int r = 0; r < (LR ? 0 : RD); ++r) { const f32x4* rp = (const f32x4*)(rope + (size_t)(row0 + (r >> 2) * 128 + (r & 3) * 16) * 16); rc[r] = rp[fq & 1]; rsn[r] = rp[2 + (fq & 1)]; }
                float rs[2][4];
#pragma unroll
                for (int ai = 0; ai < 2; ++ai)
#pragma unroll
                    for (int m = 0; m < 4; ++m) { float ss = 0.f;
#pragma unroll
                        for (int bj = 0; bj < 2; ++bj)
#pragma unroll
                            for (int n = 0; n < 2; ++n) { const f32x4 q = acc[ai][bj][m][n] * acc[ai][bj][m][n]; ss += (q[0] + q[1]) + (q[2] + q[3]); }
                        rs[ai][m] = ss; }
#pragma unroll
                for (int ai = 0; ai < 2; ++ai)
#pragma unroll
                    for (int m = 0; m < 4; ++m) rs[ai][m] += __shfl_xor(rs[ai][m], 16);
#pragma unroll
                for (int ai = 0; ai < 2; ++ai)
#pragma unroll
                    for (int m = 0; m < 4; ++m) { rs[ai][m] += __shfl_xor(rs[ai][m], 32); rs[ai][m] = __builtin_amdgcn_rsqf(rs[ai][m] * (1.f / 64.f) + EPSN); }
#pragma unroll
                for (int n = 0; n < 2; ++n) { gn[0][n] *= gs; gn[1][n] *= gs; }
#pragma unroll
                for (int ai = 0; ai < 2; ++ai)
#pragma unroll
                    for (int m = 0; m < 4; ++m) {
                        const int row = row0 + ai * 128 + m * 16, s = row & 2047, sp = ((s & ((1 << dsh) - 1)) << (11 - dsh)) + (s >> dsh);
                        const float rstd = rs[ai][m];
                        f32x4 v00 = (acc[ai][0][m][0] * rstd) * gn[0][0], v01 = (acc[ai][0][m][1] * rstd) * gn[0][1];
                        const f32x4 v10 = (acc[ai][1][m][0] * rstd) * gn[1][0], v11 = (acc[ai][1][m][1] * rstd) * gn[1][1];
                        const int r = ai * 4 + m;
                        if constexpr (LR) { const LAS f32x4* rp = (const LAS f32x4*)(lrope + (wr * 64 + fr + ai * 128 + m * 16) * 16); rc[0] = rp[fq & 1]; rsn[0] = rp[2 + (fq & 1)]; }
                        const int ri = LR ? 0 : r % RD;
                        const f32x4 r0 = v00 * rc[ri] - v01 * rsn[ri], r1 = v01 * rc[ri] + v00 * rsn[ri];
                        if (lowq) { v00 = r0; v01 = r1; }
                        const v4u p0 = pack8(v00, v01), p1 = pack8(v10, v11);
                        if constexpr (!LR) if (r + RD < 8) { const int r2 = r + RD; const f32x4* rp = (const f32x4*)(rope + (size_t)(row0 + (r2 >> 2) * 128 + (r2 & 3) * 16) * 16); rc[r % RD] = rp[fq & 1]; rsn[r % RD] = rp[2 + (fq & 1)]; }
                        asm volatile("" ::: "memory");
                        bf16* dst = base + (size_t)sp * 64;
                        *(v4u*)(dst) = p0; *(v4u*)(dst + 32) = p1;
                        if (m & 1) asm volatile("" ::: "memory");
                    }
            } else {
#pragma unroll
                for (int ai = 0; ai < 2; ++ai)
#pragma unroll
                    for (int m = 0; m < 4; ++m) {
                        const int row = row0 + ai * 128 + m * 16, s = row & 2047, sp = ((s & ((1 << dsh) - 1)) << (11 - dsh)) + (s >> dsh);
                        bf16* dst = base + (size_t)sp * 64;
                        *(v4u*)(dst) = pack8(acc[ai][0][m][0], acc[ai][0][m][1]); *(v4u*)(dst + 32) = pack8(acc[ai][1][m][0], acc[ai][1][m][1]);
                    }
            }
        } else if (pn < 20) {
            bf16* basep = ga + (pn - 18) * 256 + wc * 32 + 8 * fq;
#pragma unroll
            for (int ai = 0; ai < 2; ++ai)
#pragma unroll
                for (int m = 0; m < 4; ++m) { bf16* dst = basep + (size_t)(row0 + ai * 128 + m * 16) * 512;
#pragma unroll
                    for (int bj = 0; bj < 2; ++bj) *(v4u*)(dst + bj * 128) = pack8(silu4(acc[ai][bj][m][0]), silu4(acc[ai][bj][m][1])); }
        } else if (pn < 24) {
            bf16* basep = ug + (pn - 20) * 128 + wc * 32 + 8 * fq;
#pragma unroll
            for (int ai = 0; ai < 2; ++ai)
#pragma unroll
                for (int m = 0; m < 4; ++m) { bf16* dst = basep + (size_t)(row0 + ai * 128 + m * 16) * 512;
                    *(v4u*)(dst) = pack8(gelu4(acc[ai][0][m][0]) * silu4(acc[ai][1][m][0]), gelu4(acc[ai][0][m][1]) * silu4(acc[ai][1][m][1])); }
        } else if (pn < 26) {
            bf16* basep = vg + (pn - 24) * 256 + wc * 32 + 8 * fq;
#pragma unroll
            for (int ai = 0; ai < 2; ++ai)
#pragma unroll
                for (int m = 0; m < 4; ++m) { const int row = row0 + ai * 128 + m * 16; bf16* dst = basep + (size_t)row * 512; float s1 = 0.f, s2 = 0.f;
#pragma unroll
                    for (int bj = 0; bj < 2; ++bj) { const f32x4 a = gelu4(acc[ai][bj][m][0]), c = gelu4(acc[ai][bj][m][1]);
                        s1 += ((a[0] + a[1]) + (a[2] + a[3])) + ((c[0] + c[1]) + (c[2] + c[3]));
                        const f32x4 a2 = a * a, c2 = c * c; s2 += ((a2[0] + a2[1]) + (a2[2] + a2[3])) + ((c2[0] + c2[1]) + (c2[2] + c2[3]));
                        *(v4u*)(dst + bj * 128) = pack8(a, c); }
                    s1 += __shfl_xor(s1, 16); s1 += __shfl_xor(s1, 32); s2 += __shfl_xor(s2, 16); s2 += __shfl_xor(s2, 32);
                    if (fq == 0) *(f32x2*)(stats + ((size_t)row * 8 + (pn - 24) * 4 + wc) * 2) = (f32x2){s1, s2}; }
        } else {
            const int cb = (pn - 26) * 128 + wc * 32 + 8 * fq;
#pragma unroll
            for (int ai = 0; ai < 2; ++ai)
#pragma unroll
                for (int m = 0; m < 4; ++m) { const size_t ro = ovl_row(row0 + ai * 128 + m * 16) + cb;
                    f32x4 a0 = sigm4(acc[ai][0][m][0]), a1 = sigm4(acc[ai][0][m][1]), b0 = sigm4(acc[ai][1][m][0]), b1 = sigm4(acc[ai][1][m][1]);
#pragma unroll
                    for (int e = 0; e < 4; ++e) { b0[e] = fmaxf(b0[e], 1e-18f); b1[e] = fmaxf(b1[e], 1e-18f); a0[e] *= __builtin_amdgcn_rcpf(b0[e]); a1[e] *= __builtin_amdgcn_rcpf(b1[e]); }
                    *(v4u*)(ma + ro) = pack8(a0, a1); *(v4u*)(mb + ro) = pack8(b0, b1); }
        }
    }
};
typedef EpiZT<false> EpiZ;
struct EpiMrg {
    static constexpr bool PERM = true, AFTER_DRAIN = false, CARRY = true;
    const bf16* rat; const bf16* fin; bf16* merged;
    __device__ __forceinline__ bool carry(const pg8::Unit& u) const { return u.pm < 64; }
    __device__ __forceinline__ void operator()(pg8::f32x4 (&acc)[2][2][4][2], const pg8::Unit& u, int wr, int wc, int fr, int fq) const {
        const bool first = u.pm < 64; const int pm = u.pm & 63, pn = u.pn & 3;
        const int row0 = pm * 256 + wr * 64 + fr, col0 = pn * 256 + wc * 32 + 8 * fq;
        const bf16* gsrc = first ? rat : fin;
        constexpr int GD = 3; v4u gr[GD][2];
#pragma unroll
        for (int r = 0; r < GD; ++r) { const size_t ro = ovl_row(row0 + (r >> 2) * 128 + (r & 3) * 16) + col0; gr[r][0] = *(const v4u*)(gsrc + ro); gr[r][1] = *(const v4u*)(gsrc + ro + 128); }
#pragma unroll
        for (int r = 0; r < 8; ++r) { const int ai = r >> 2, m = r & 3; const size_t ro = ovl_row(row0 + ai * 128 + m * 16) + col0;
            v4u o[2];
#pragma unroll
            for (int bj = 0; bj < 2; ++bj) { const v4u gw = gr[r % GD][bj];
                const f32x4 g0 = {bflo(gw.x), bfhi(gw.x), bflo(gw.y), bfhi(gw.y)}, g1 = {bflo(gw.z), bfhi(gw.z), bflo(gw.w), bfhi(gw.w)};
                if (first) { acc[ai][bj][m][0] *= g0; acc[ai][bj][m][1] *= g1; }
                else o[bj] = pack8(g0 * acc[ai][bj][m][0], g1 * acc[ai][bj][m][1]); }
            if (r + GD < 8) { const int r2 = r + GD; const size_t ro2 = ovl_row(row0 + (r2 >> 2) * 128 + (r2 & 3) * 16) + col0; gr[r % GD][0] = *(const v4u*)(gsrc + ro2); gr[r % GD][1] = *(const v4u*)(gsrc + ro2 + 128); }
            asm volatile("" ::: "memory");
            if (!first) { *(v4u*)(merged + ro) = o[0]; *(v4u*)(merged + ro + 128) = o[1]; }
        }
    }
};
struct EpiOut {
    static constexpr bool PERM = true, AFTER_DRAIN = false, CARRY = false;
    const float* x; const float* ada; float* out;
    __device__ __forceinline__ void operator()(const pg8::f32x4 (&acc)[2][2][4][2], const pg8::Unit& u, int wr, int wc, int fr, int fq) const {
        const int row0 = u.pm * 256 + wr * 64 + fr, col0 = u.pn * 256 + wc * 32 + 8 * fq, b = u.pm >> 3;
        f32x4 gt[2][2];
#pragma unroll
        for (int bj = 0; bj < 2; ++bj)
#pragma unroll
            for (int n = 0; n < 2; ++n) gt[bj][n] = *(const f32x4*)(ada + b * 3072 + 2048 + col0 + bj * 128 + 4 * n);
        constexpr int XD = 2; f32x4 xr[XD][2][2];
#pragma unroll
        for (int r = 0; r < XD; ++r) { const size_t ro = (size_t)(row0 + (r >> 2) * 128 + (r & 3) * 16) * 1024 + col0;
#pragma unroll
            for (int bj = 0; bj < 2; ++bj)
#pragma unroll
                for (int n = 0; n < 2; ++n) xr[r][bj][n] = *(const f32x4*)(x + ro + bj * 128 + 4 * n); }
#pragma unroll
        for (int r = 0; r < 8; ++r) { const int ai = r >> 2, m = r & 3; const size_t ro = (size_t)(row0 + ai * 128 + m * 16) * 1024 + col0;
            f32x4 o[2][2];
#pragma unroll
            for (int bj = 0; bj < 2; ++bj)
#pragma unroll
                for (int n = 0; n < 2; ++n) o[bj][n] = xr[r % XD][bj][n] + gt[bj][n] * acc[ai][bj][m][n];
            if (r + XD < 8) { const int r2 = r + XD; const size_t ro2 = (size_t)(row0 + (r2 >> 2) * 128 + (r2 & 3) * 16) * 1024 + col0;
#pragma unroll
                for (int bj = 0; bj < 2; ++bj)
#pragma unroll
                    for (int n = 0; n < 2; ++n) xr[r % XD][bj][n] = *(const f32x4*)(x + ro2 + bj * 128 + 4 * n); }
            asm volatile("" ::: "memory");
#pragma unroll
            for (int bj = 0; bj < 2; ++bj)
#pragma unroll
                for (int n = 0; n < 2; ++n) *(f32x4*)(out + ro + bj * 128 + 4 * n) = o[bj][n];
        }
    }
};
struct MergeOrder {
    int G, c;
    __device__ __forceinline__ bool next(int i, pg8::Unit& u) const {
        const int p = (i >> 1) * G + c; if (p >= 256) return false;
        const int x = p & 7, idx = p >> 3; u.pm = 8 * x + (idx & 7); u.pn = 26 + 2 * (idx >> 3) + (i & 1); return true;
    }
    __device__ __forceinline__ void a_ready(const pg8::Unit&) const {}
    __device__ __forceinline__ void done(const pg8::Unit&) const {}
};
constexpr unsigned NWAVES_HOOK = 8;
struct RangeOrder {
    pg8::StaticOrder S; int i0, n;
    int hook_after = 0; XcdBarrier hb{}; volatile LAS unsigned* wcnt = nullptr; mutable int ndone = 0;
    __device__ __forceinline__ bool next(int i, pg8::Unit& u) const { return i < n && S.next(i0 + i, u); }
    __device__ __forceinline__ void a_ready(const pg8::Unit&) const {}
    __device__ __forceinline__ void done(const pg8::Unit&) const {
        if (++ndone != hook_after) return;
        asm volatile("s_waitcnt vmcnt(0)" ::: "memory");
        unsigned c = 0u; if ((threadIdx.x & 63) == 0) c = __hip_atomic_fetch_add((LAS unsigned*)wcnt, 1u, __ATOMIC_RELAXED, __HIP_MEMORY_SCOPE_WORKGROUP);
        c = (unsigned)__builtin_amdgcn_readfirstlane((int)c);
        if (c == NWAVES_HOOK - 1 && (threadIdx.x & 63) == 0) xcd_local_arrive(hb);
    }
};
struct PairOrder {
    int G, c;
    __device__ __forceinline__ bool next(int i, pg8::Unit& u) const {
        const int p = (i >> 1) * G + c; if (p >= 256) return false;
        const int x = p & 7, idx = p >> 3; int pm = 8 * x + (idx & 7), pn = idx >> 3;
        if (i & 1) { pm += 64; pn += 4; }
        u.pm = pm; u.pn = pn; return true;
    }
    __device__ __forceinline__ void a_ready(const pg8::Unit&) const {}
    __device__ __forceinline__ void done(const pg8::Unit&) const {}
};

namespace att {
__device__ __forceinline__ int crow(int r, int hi) { return (r & 3) + 8 * (r >> 2) + 4 * hi; }
__device__ __forceinline__ v4i16_t vtr(const LAS unsigned char* p) { return __builtin_amdgcn_ds_read_tr16_b64_v4i16((LAS v4i16_t*)p); }
}


namespace att2 {
constexpr int KR = 0, VR = 49152, XO = 98304, XL = 131072, XL2 = 132096, NITEM = 8 * 3 * 8 * 16;
#define A2_LGKM() asm volatile("s_waitcnt lgkmcnt(0)" ::: "memory")
#define A2_BAR() do { asm volatile("s_waitcnt lgkmcnt(0)" ::: "memory"); __builtin_amdgcn_s_barrier(); asm volatile("" ::: "memory"); } while (0)
__device__ __forceinline__ void glds16(const void* gsrc, unsigned lds_dst) { unsigned keep;
    asm volatile("s_mov_b32 %0, m0\n\ts_mov_b32 m0, %2\n\ts_nop 0\n\tglobal_load_lds_dwordx4 %1, off\n\ts_mov_b32 m0, %0" : "=&s"(keep) : "v"(gsrc), "s"(lds_dst) : "memory"); }
__device__ __forceinline__ void issue_dma(int a, int k, int tau0, bf16* qkv, unsigned lds0, int wid, int lane) {
    const int n16 = a & 15, h = (a >> 4) & 7, bg = a >> 7, g = bg % 3, Lsh = 11 - 2 * g, cs = ((128 * n16) >> Lsh) << Lsh, sbase = 128 * n16 - 128;
    const bf16* Ks = qkv + (size_t)((bg * 3 * 8 + 8 + h) * 2048) * 64; const bf16* Vs = Ks + (size_t)8 * 2048 * 64;
#pragma unroll
    for (int tile = 0; tile < 4; ++tile) { const int ks0 = sbase + 64 * tile;
        if (tile >= tau0 && ks0 >= cs) { const int slot = (2 * k + tile) % 6;
            glds16(Ks + (size_t)(ks0 + lane) * 64 + wid * 8, (unsigned)__builtin_amdgcn_readfirstlane((int)(lds0 + KR + slot * 8192 + wid * 1024)));
            glds16(Vs + (size_t)(ks0 + 16 * (wid & 3) + (lane >> 2)) * 64 + (wid >> 2) * 32 + (lane & 3) * 8, (unsigned)__builtin_amdgcn_readfirstlane((int)(lds0 + VR + slot * 8192 + wid * 1024)));
        } }
}
__device__ __forceinline__ void attn_phase(int a0, int cnt, bf16* qkv, float* lse, const float* ref2tab, LAS unsigned char* lds) {
    const int tid = threadIdx.x, lane = tid & 63, r32 = lane & 31, hi = lane >> 5, wid = __builtin_amdgcn_readfirstlane(tid >> 6);
    const int qg = wid & 3, half = wid >> 2, qodd = qg & 1, c = 32 * qodd + r32;
    const float rf0 = __hip_atomic_load(ref2tab + 0, __ATOMIC_RELAXED, __HIP_MEMORY_SCOPE_AGENT), rf1 = __hip_atomic_load(ref2tab + 1, __ATOMIC_RELAXED, __HIP_MEMORY_SCOPE_AGENT), rf2 = __hip_atomic_load(ref2tab + 2, __ATOMIC_RELAXED, __HIP_MEMORY_SCOPE_AGENT);
    if (cnt <= 0) return;
    __syncthreads();
    const unsigned lds0 = (unsigned)(uintptr_t)(unsigned char*)lds;
    bf16x8 qr[4], qn[4];
    issue_dma(a0, 0, 0, qkv, lds0, wid, lane);
    { const int n16 = a0 & 15, h = (a0 >> 4) & 7, bg = a0 >> 7; const bf16* Qs = qkv + (size_t)((bg * 3 * 8 + h) * 2048) * 64 + (size_t)(128 * n16 + 32 * qg + r32) * 64;
#pragma unroll
      for (int d0 = 0; d0 < 4; ++d0) qn[d0] = *(const bf16x8*)(Qs + d0 * 16 + hi * 8); }
    for (int k = 0; k < cnt; ++k) {
        const int a = a0 + k;
        if (k == 0) asm volatile("s_waitcnt vmcnt(0)" ::: "memory"); else if (half) asm volatile("s_waitcnt vmcnt(2)" ::: "memory"); else asm volatile("s_waitcnt vmcnt(3)" ::: "memory");
        asm volatile("" : "+v"(qn[0]), "+v"(qn[1]), "+v"(qn[2]), "+v"(qn[3]));
#pragma unroll
        for (int d0 = 0; d0 < 4; ++d0) qr[d0] = qn[d0];
        A2_BAR();
        const bool has_next = k + 1 < cnt;
        if (has_next) issue_dma(a + 1, k + 1, 2, qkv, lds0, wid, lane);
        const int n16 = a & 15, h = (a >> 4) & 7, bg = a >> 7, g = bg % 3, b = bg / 3, Lsh = 11 - 2 * g, cs = ((128 * n16) >> Lsh) << Lsh, sbase = 128 * n16 - 128;
        const float ref2 = (g == 0) ? rf0 : (g == 1) ? rf1 : rf2;
        const LAS unsigned char* kbase = lds + KR + hi * 1024 + r32 * 16;
        const LAS unsigned char* vbase = lds + VR + ((lane >> 4) & 1) * 32 + (lane & 3) * 8 + (4 * hi + ((lane & 15) >> 2)) * 64;
        f32x16 o0, o1;
#pragma unroll
        for (int r = 0; r < 16; ++r) { o0[r] = 0.f; o1[r] = 0.f; }
        float l = 0.f;
#define A2_STEP(S, HS, MODE, GUARD) do { const int tile_ = (qg >> 1) + (S); if (!(GUARD) || sbase + 64 * tile_ >= cs) { const int so_ = ((2 * k + tile_) % 6) * 8192; \
            f32x16 p_; _Pragma("unroll") for (int r = 0; r < 16; ++r) p_[r] = -ref2; \
            _Pragma("unroll") for (int d0 = 0; d0 < 4; ++d0) { const bf16x8 kf_ = *(const LAS bf16x8*)(kbase + so_ + d0 * 2048 + (HS) * 512); p_ = __builtin_amdgcn_mfma_f32_32x32x16_bf16(kf_, qr[d0], p_, 0, 0, 0); } \
            _Pragma("unroll") for (int r = 0; r < 16; ++r) { const int kvl_ = att::crow(r, hi) + 32 * (HS); const bool v_ = ((MODE) == 0) ? true : ((MODE) == 1) ? (kvl_ >= c) : (kvl_ <= c); \
                const float e_ = v_ ? __builtin_amdgcn_exp2f(p_[r]) : 0.f; p_[r] = e_; l += e_; } \
            const v4u w0_ = {pg8::cvt_pk_bf16(p_[0], p_[1]), pg8::cvt_pk_bf16(p_[2], p_[3]), pg8::cvt_pk_bf16(p_[4], p_[5]), pg8::cvt_pk_bf16(p_[6], p_[7])}; \
            const v4u w1_ = {pg8::cvt_pk_bf16(p_[8], p_[9]), pg8::cvt_pk_bf16(p_[10], p_[11]), pg8::cvt_pk_bf16(p_[12], p_[13]), pg8::cvt_pk_bf16(p_[14], p_[15])}; \
            _Pragma("unroll") for (int j_ = 0; j_ < 2; ++j_) { const bf16x8 pa_ = __builtin_bit_cast(bf16x8, j_ ? w1_ : w0_); const int ko_ = so_ + (2 * (HS) + j_) * 1024; \
                { const v4i16_t lo_ = att::vtr(vbase + ko_), hh_ = att::vtr(vbase + ko_ + 512); o0 = __builtin_amdgcn_mfma_f32_32x32x16_bf16(pa_, (bf16x8){lo_[0], lo_[1], lo_[2], lo_[3], hh_[0], hh_[1], hh_[2], hh_[3]}, o0, 0, 0, 0); } \
                { const v4i16_t lo_ = att::vtr(vbase + ko_ + 4096), hh_ = att::vtr(vbase + ko_ + 4096 + 512); o1 = __builtin_amdgcn_mfma_f32_32x32x16_bf16(pa_, (bf16x8){lo_[0], lo_[1], lo_[2], lo_[3], hh_[0], hh_[1], hh_[2], hh_[3]}, o1, 0, 0, 0); } } \
        } } while (0)
        if (sbase >= cs) {
            if (!qodd) { if (!half) { A2_STEP(0, 0, 1, 0); A2_STEP(0, 1, 0, 0); A2_STEP(1, 0, 0, 0); } else { A2_STEP(1, 1, 0, 0); A2_STEP(2, 0, 2, 0); } }
            else       { if (!half) { A2_STEP(0, 1, 1, 0); A2_STEP(1, 0, 0, 0); A2_STEP(1, 1, 0, 0); } else { A2_STEP(2, 0, 0, 0); A2_STEP(2, 1, 2, 0); } }
        } else {
            if (!qodd) { if (!half) { A2_STEP(0, 0, 1, 1); A2_STEP(0, 1, 0, 1); A2_STEP(1, 0, 0, 1); } else { A2_STEP(1, 1, 0, 1); A2_STEP(2, 0, 2, 1); } }
            else       { if (!half) { A2_STEP(0, 1, 1, 1); A2_STEP(1, 0, 0, 1); A2_STEP(1, 1, 0, 1); } else { A2_STEP(2, 0, 0, 1); A2_STEP(2, 1, 2, 1); } }
        }
#undef A2_STEP
        if (has_next) {
            const int an = a + 1, n16n = an & 15, hn = (an >> 4) & 7, bgn = an >> 7; const bf16* Qs = qkv + (size_t)((bgn * 3 * 8 + hn) * 2048) * 64 + (size_t)(128 * n16n + 32 * qg + r32) * 64;
#pragma unroll
            for (int d0 = 0; d0 < 4; ++d0) qn[d0] = *(const bf16x8*)(Qs + d0 * 16 + hi * 8); }
        LAS f32x4* xo = (LAS f32x4*)(lds + XO); LAS float* xl = (LAS float*)(lds + XL); LAS float* xl2 = (LAS float*)(lds + XL2);
#pragma unroll
        for (int q4 = 0; q4 < 4; ++q4) xo[((qg * 2 + (half ^ 1)) * 4 + q4) * 64 + lane] = half ? (f32x4){o0[4 * q4], o0[4 * q4 + 1], o0[4 * q4 + 2], o0[4 * q4 + 3]} : (f32x4){o1[4 * q4], o1[4 * q4 + 1], o1[4 * q4 + 2], o1[4 * q4 + 3]};
        xl[(qg * 2 + half) * 64 + lane] = l;
        A2_BAR();
        {
            f32x16 om;
#pragma unroll
            for (int q4 = 0; q4 < 4; ++q4) { const f32x4 u = xo[((qg * 2 + half) * 4 + q4) * 64 + lane];
#pragma unroll
                for (int e = 0; e < 4; ++e) om[4 * q4 + e] = (half ? o1[4 * q4 + e] : o0[4 * q4 + e]) + u[e]; }
            l += xl[(qg * 2 + (half ^ 1)) * 64 + lane];
            l += __shfl_xor(l, 32);
            if (hi == 0) xl2[(qg * 2 + half) * 32 + r32] = l;
            A2_LGKM();
            LAS bf16* stg = (LAS bf16*)(lds + XO) + (qg * 2 + half) * 2048;
#pragma unroll
            for (int r = 0; r < 16; ++r) { const int orow = att::crow(r, hi); stg[orow * 32 + r32] = (bf16)f2bf(om[r] * __builtin_amdgcn_rcpf(xl2[(qg * 2 + half) * 32 + orow])); }
            A2_LGKM();
            bf16* Ow = qkv + (size_t)((bg * 3 * 8 + h) * 2048) * 64 + (size_t)(128 * n16 + 32 * qg) * 64 + half * 32;
#pragma unroll
            for (int i = 0; i < 2; ++i) { const int row = i * 16 + (lane >> 2), ch = lane & 3; const v4u v = *(const LAS v4u*)(stg + row * 32 + ch * 8); *(v4u*)(Ow + (size_t)row * 64 + ch * 8) = v; }
            if (!half && hi == 0) lse[((size_t)(g * 8 + b) * 8 + h) * 2048 + 128 * n16 + 32 * qg + r32] = (__builtin_amdgcn_logf(l) + ref2) * LN2;
        }
    }
    A2_LGKM(); __syncthreads();
}
}

__device__ __forceinline__ void gmlp_item(int idx, const bf16* vg, bf16* ug, const float* stats, const bf16* wsp, const float* bsp, const float* lng, const float* lnb, LAS unsigned char* lds) {
    const int tid = threadIdx.x, lane = tid & 63, r32 = lane & 31, hi = lane >> 5, wid = __builtin_amdgcn_readfirstlane(tid >> 6);
    const int g = idx & 7, nc = (idx >> 3) & 15, b = idx >> 7, tok0 = b * 2048 + nc * 128, c0 = 64 * g;
    const int s = tid >> 2, part = tid & 3; const size_t tok = (size_t)tok0 + s;
    constexpr int SVOFF = 16384, SVP = 65;
    __syncthreads();
    {
        const f32x4* sp = (const f32x4*)(stats + tok * 16); const f32x4 a0 = sp[0], a1 = sp[1], a2 = sp[2], a3 = sp[3];
        const float s1 = ((a0[0] + a0[2]) + (a1[0] + a1[2])) + ((a2[0] + a2[2]) + (a3[0] + a3[2])), s2 = ((a0[1] + a0[3]) + (a1[1] + a1[3])) + ((a2[1] + a2[3]) + (a3[1] + a3[3]));
        const float mean = s1 * (1.f / 512.f), var = fmaxf(s2 * (1.f / 512.f) - mean * mean, 0.f), rstd = __builtin_amdgcn_rsqf(var + EPSN);
        const v4u* vp = (const v4u*)(vg + tok * 512 + c0 + part * 16); const v4u w0 = vp[0], w1 = vp[1];
        const f32x4* gp = (const f32x4*)(lng + c0 + part * 16); const f32x4* bp = (const f32x4*)(lnb + c0 + part * 16);
        f32x4 x0 = {bflo(w0.x), bfhi(w0.x), bflo(w0.y), bfhi(w0.y)}, x1 = {bflo(w0.z), bfhi(w0.z), bflo(w0.w), bfhi(w0.w)};
        f32x4 x2 = {bflo(w1.x), bfhi(w1.x), bflo(w1.y), bfhi(w1.y)}, x3 = {bflo(w1.z), bfhi(w1.z), bflo(w1.w), bfhi(w1.w)};
        x0 = ((x0 - mean) * rstd) * gp[0] + bp[0]; x1 = ((x1 - mean) * rstd) * gp[1] + bp[1]; x2 = ((x2 - mean) * rstd) * gp[2] + bp[2]; x3 = ((x3 - mean) * rstd) * gp[3] + bp[3];
        LAS unsigned char* dst = lds + (s >> 6) * 8192 + (part >> 1) * 4096 + ((s & 63) >> 4) * 1024 + (s & 15) * 64 + (part & 1) * 32;
        *(LAS v4u*)(dst) = pack8(x0, x1); *(LAS v4u*)(dst + 16) = pack8(x2, x3);
    }
    __syncthreads();
    {
        const int tt = wid >> 1, ct = wid & 1;
        f32x16 acc;
#pragma unroll
        for (int r = 0; r < 16; ++r) acc[r] = 0.f;
        const bf16* wrow = wsp + (size_t)(g * 128 + 32 * tt + r32) * 128 + 8 * hi;
        const LAS unsigned char* bb = lds + ct * 4096 + (8 * hi + ((lane & 15) >> 2)) * 64 + ((lane >> 4) & 1) * 32 + (lane & 3) * 8;
#pragma unroll
        for (int ks = 0; ks < 8; ++ks) if (ks < 2 * (tt + 1)) {
            const bf16x8 A = *(const bf16x8*)(wrow + 16 * ks);
            const LAS unsigned char* b2 = bb + (ks >> 2) * 8192 + (ks & 3) * 1024;
            const v4i16_t lo = att::vtr(b2), hh = att::vtr(b2 + 256);
            acc = __builtin_amdgcn_mfma_f32_32x32x16_bf16(A, (bf16x8){lo[0], lo[1], lo[2], lo[3], hh[0], hh[1], hh[2], hh[3]}, acc, 0, 0, 0);
        }
        LAS float* sv = (LAS float*)(lds + SVOFF);
#pragma unroll
        for (int r = 0; r < 16; ++r) sv[(32 * tt + att::crow(r, hi)) * SVP + 32 * ct + r32] = acc[r];
    }
    __syncthreads();
    {
        const LAS float* sv = (const LAS float*)(lds + SVOFF) + s * SVP + part * 16; const float bs = bsp[g * 128 + s];
        bf16* up = ug + tok * 512 + c0 + part * 16; const v4u w0 = *(const v4u*)up, w1 = *(const v4u*)(up + 8);
        f32x4 y0 = {bflo(w0.x) * (sv[0] + bs), bfhi(w0.x) * (sv[1] + bs), bflo(w0.y) * (sv[2] + bs), bfhi(w0.y) * (sv[3] + bs)};
        f32x4 y1 = {bflo(w0.z) * (sv[4] + bs), bfhi(w0.z) * (sv[5] + bs), bflo(w0.w) * (sv[6] + bs), bfhi(w0.w) * (sv[7] + bs)};
        f32x4 y2 = {bflo(w1.x) * (sv[8] + bs), bfhi(w1.x) * (sv[9] + bs), bflo(w1.y) * (sv[10] + bs), bfhi(w1.y) * (sv[11] + bs)};
        f32x4 y3 = {bflo(w1.z) * (sv[12] + bs), bfhi(w1.z) * (sv[13] + bs), bflo(w1.w) * (sv[14] + bs), bfhi(w1.w) * (sv[15] + bs)};
        *(v4u*)up = pack8(y0, y1); *(v4u*)(up + 8) = pack8(y2, y3);
    }
}


__device__ __forceinline__ float wave_sum(float v);


constexpr int G2_STRIDE = 49664;
__device__ __forceinline__ void gmlp_items2(int idx0, int idx1, const bf16* vg, bf16* ug, const float* stats, const bf16* wsp, const float* bsp, const float* lng, const float* lnb, LAS unsigned char* lds) {
    const int tid = threadIdx.x, lane = tid & 63, r32 = lane & 31, hi = lane >> 5, wid = __builtin_amdgcn_readfirstlane(tid >> 6);
    const int s = tid >> 2, part = tid & 3;
    constexpr int SVOFF = 16384, SVP = 65;
    int gg[2], c0[2]; size_t tok[2]; v4u uw0[2], uw1[2]; float bs[2];
#pragma unroll
    for (int j = 0; j < 2; ++j) { const int idx = j ? idx1 : idx0; gg[j] = idx & 7; c0[j] = 64 * gg[j]; tok[j] = (size_t)((idx >> 7) * 2048 + ((idx >> 3) & 15) * 128) + s; }
    __syncthreads();
#pragma unroll
    for (int j = 0; j < 2; ++j) {
        const f32x4* sp = (const f32x4*)(stats + tok[j] * 16); const f32x4 a0 = sp[0], a1 = sp[1], a2 = sp[2], a3 = sp[3];
        const v4u* vp = (const v4u*)(vg + tok[j] * 512 + c0[j] + part * 16); const v4u w0 = vp[0], w1 = vp[1];
        const bf16* up = ug + tok[j] * 512 + c0[j] + part * 16; uw0[j] = *(const v4u*)up; uw1[j] = *(const v4u*)(up + 8); bs[j] = bsp[gg[j] * 128 + s];
        const float s1 = ((a0[0] + a0[2]) + (a1[0] + a1[2])) + ((a2[0] + a2[2]) + (a3[0] + a3[2])), s2 = ((a0[1] + a0[3]) + (a1[1] + a1[3])) + ((a2[1] + a2[3]) + (a3[1] + a3[3]));
        const float mean = s1 * (1.f / 512.f), var = fmaxf(s2 * (1.f / 512.f) - mean * mean, 0.f), rstd = __builtin_amdgcn_rsqf(var + EPSN);
        const f32x4* gp = (const f32x4*)(lng + c0[j] + part * 16); const f32x4* bp = (const f32x4*)(lnb + c0[j] + part * 16);
        f32x4 x0 = {bflo(w0.x), bfhi(w0.x), bflo(w0.y), bfhi(w0.y)}, x1 = {bflo(w0.z), bfhi(w0.z), bflo(w0.w), bfhi(w0.w)};
        f32x4 x2 = {bflo(w1.x), bfhi(w1.x), bflo(w1.y), bfhi(w1.y)}, x3 = {bflo(w1.z), bfhi(w1.z), bflo(w1.w), bfhi(w1.w)};
        x0 = ((x0 - mean) * rstd) * gp[0] + bp[0]; x1 = ((x1 - mean) * rstd) * gp[1] + bp[1]; x2 = ((x2 - mean) * rstd) * gp[2] + bp[2]; x3 = ((x3 - mean) * rstd) * gp[3] + bp[3];
        LAS unsigned char* dst = lds + j * G2_STRIDE + (s >> 6) * 8192 + (part >> 1) * 4096 + ((s & 63) >> 4) * 1024 + (s & 15) * 64 + (part & 1) * 32;
        *(LAS v4u*)(dst) = pack8(x0, x1); *(LAS v4u*)(dst + 16) = pack8(x2, x3);
    }
    __syncthreads();
    {
        const int tt = wid >> 1, ct = wid & 1;
#pragma unroll
        for (int j = 0; j < 2; ++j) {
            f32x16 acc;
#pragma unroll
            for (int r = 0; r < 16; ++r) acc[r] = 0.f;
            const bf16* wrow = wsp + (size_t)(gg[j] * 128 + 32 * tt + r32) * 128 + 8 * hi;
            const LAS unsigned char* bb = lds + j * G2_STRIDE + ct * 4096 + (8 * hi + ((lane & 15) >> 2)) * 64 + ((lane >> 4) & 1) * 32 + (lane & 3) * 8;
#pragma unroll
            for (int ks = 0; ks < 8; ++ks) if (ks < 2 * (tt + 1)) {
                const bf16x8 A = *(const bf16x8*)(wrow + 16 * ks);
                const LAS unsigned char* b2 = bb + (ks >> 2) * 8192 + (ks & 3) * 1024;
                const v4i16_t lo = att::vtr(b2), hh = att::vtr(b2 + 256);
                acc = __builtin_amdgcn_mfma_f32_32x32x16_bf16(A, (bf16x8){lo[0], lo[1], lo[2], lo[3], hh[0], hh[1], hh[2], hh[3]}, acc, 0, 0, 0);
            }
            LAS float* sv = (LAS float*)(lds + j * G2_STRIDE + SVOFF);
#pragma unroll
            for (int r = 0; r < 16; ++r) sv[(32 * tt + att::crow(r, hi)) * SVP + 32 * ct + r32] = acc[r];
        }
    }
    __syncthreads();
#pragma unroll
    for (int j = 0; j < 2; ++j) {
        const LAS float* sv = (const LAS float*)(lds + j * G2_STRIDE + SVOFF) + s * SVP + part * 16; const float b_ = bs[j];
        bf16* up = ug + tok[j] * 512 + c0[j] + part * 16; const v4u w0 = uw0[j], w1 = uw1[j];
        f32x4 y0 = {bflo(w0.x) * (sv[0] + b_), bfhi(w0.x) * (sv[1] + b_), bflo(w0.y) * (sv[2] + b_), bfhi(w0.y) * (sv[3] + b_)};
        f32x4 y1 = {bflo(w0.z) * (sv[4] + b_), bfhi(w0.z) * (sv[5] + b_), bflo(w0.w) * (sv[6] + b_), bfhi(w0.w) * (sv[7] + b_)};
        f32x4 y2 = {bflo(w1.x) * (sv[8] + b_), bfhi(w1.x) * (sv[9] + b_), bflo(w1.y) * (sv[10] + b_), bfhi(w1.y) * (sv[11] + b_)};
        f32x4 y3 = {bflo(w1.z) * (sv[12] + b_), bfhi(w1.z) * (sv[13] + b_), bflo(w1.w) * (sv[14] + b_), bfhi(w1.w) * (sv[15] + b_)};
        *(v4u*)up = pack8(y0, y1); *(v4u*)(up + 8) = pack8(y2, y3);
    }
}

struct Args { const float* x; const float* c; const int* pos; const float* norm_g; const float* w_ada; const float* b_ada; const float* w_in; const float* qg; const float* kg;
              const float* lng; const float* lnb; const float* wsp; const float* bsp; const float* wa; const float* wb; const float* wout;
              float* out; unsigned char* ws; int ph_lo, ph_hi, li, pad; };

__device__ __forceinline__ float wave_sum(float v) {
#pragma unroll
    for (int o = 1; o < 64; o <<= 1) v += __shfl_xor(v, o);
    return v;
}
__host__ __device__ __forceinline__ int qk_perm(int p) { return p < 16 ? ((p & 4) << 1) | ((p & 8) >> 1) | (p & 3) : p; }
__device__ __forceinline__ void transpose_item(const float* W, int K, int N, bf16* WT, int src0, int dst0, int k0, LAS float* scr, int lane, bool permq = false) {
#pragma unroll 32
    for (int i = 0; i < 32; ++i) { const int kk = 2 * i + (lane >> 5); scr[kk * 33 + (lane & 31)] = W[(size_t)(k0 + kk) * N + src0 + (lane & 31)]; }
    LDS_WAIT(); asm volatile("" ::: "memory");
    const int c = lane & 7;
#pragma unroll
    for (int j = 0; j < 4; ++j) { const int n = (lane >> 3) + 8 * j; const LAS float* s = scr + (8 * c) * 33 + (permq ? qk_perm(n) : n);
        v4u o; o.x = pk2(s[0 * 33], s[1 * 33]); o.y = pk2(s[2 * 33], s[3 * 33]); o.z = pk2(s[4 * 33], s[5 * 33]); o.w = pk2(s[6 * 33], s[7 * 33]);
        *(GAS v4u*)(WT + (size_t)(dst0 + n) * K + k0 + 8 * c) = o; }
    LDS_WAIT(); asm volatile("" ::: "memory");
}

__global__ void __launch_bounds__(NWAVES * 64, 2) fwd_kernel(Args args) {
    extern __shared__ __attribute__((aligned(16))) unsigned char lds_raw[];
    LAS unsigned char* lds = (LAS unsigned char*)lds_raw;
    volatile LAS unsigned* MISC = (volatile LAS unsigned*)(lds + MISC_OFF);
    const int tid = threadIdx.x, lane = tid & 63, wave = __builtin_amdgcn_readfirstlane(tid >> 6);
    const int G = gridDim.x; const int bx = blockIdx.x; const int vcu = (G % 8 == 0) ? (bx % 8) * (G / 8) + bx / 8 : bx;
    unsigned char* ws = args.ws;
    gu32* ctl = (gu32*)(ws + WS_CTL);
    float* ada = (float*)(ws + WS_ADA); float* ref2tab = (float*)(ws + WS_MISC); bf16* wspb = (bf16*)(ws + WS_WSP); float* lse = (float*)(ws + WS_LSE);
    float* stats = (float*)(ws + WS_STATS); float* rope = (float*)(ws + WS_ROPE);
    bf16* win_t = (bf16*)(ws + WS_WIN); bf16* wa_t = (bf16*)(ws + WS_WA); bf16* wb_t = (bf16*)(ws + WS_WB); bf16* wout_t = (bf16*)(ws + WS_WOUT);
    bf16* qkv = (bf16*)(ws + WS_QKV); bf16* ga = (bf16*)(ws + WS_GA); bf16* ug = (bf16*)(ws + WS_UG); bf16* vg = (bf16*)(ws + WS_VG); bf16* mb = (bf16*)(ws + WS_MBO);
    bf16* merged = (bf16*)(ws + WS_MERGED);
    bf16* hbuf = (bf16*)(ws + WS_H); bf16* ma = (bf16*)(ws + WS_MA);

    for (int u = tid; u < (LDS_BYTES - LDSCTL_OFF) / 4; u += NWAVES * 64) ((LAS unsigned*)(lds + LDSCTL_OFF))[u] = 0u;
    __syncthreads();
    XcdBarrier bar; bar.bar = (unsigned*)(ctl + CW_BAR); bar.x = 0; bar.st = nullptr;
    if (N_LAUNCHES == 1) { bar = xcd_barrier_post((unsigned*)(ctl + CW_BAR), MISC + 8);
        if (tid == 0) (void)__hip_atomic_fetch_or((unsigned*)(ctl + CW_GRP + (bx & 7)), 1u << bar.x, RLX_AGENT); }
    const int lo = args.ph_lo, hi = args.ph_hi;
    if (N_LAUNCHES != 1) { __builtin_amdgcn_fence(__ATOMIC_RELEASE, "agent"); asm volatile("s_waitcnt vmcnt(0)" ::: "memory"); __builtin_amdgcn_fence(__ATOMIC_ACQUIRE, "agent"); asm volatile("s_waitcnt vmcnt(0)" ::: "memory"); __syncthreads(); }
#define IN(k) (lo <= (k) && (k) < hi)
#define SEAM(k) do { if (lo <= (k) && (k) + 1 < hi) xcd_barrier(bar); } while (0)
    bool fastb = false;
#define SEAML(k) do { if (lo <= (k) && (k) + 1 < hi) { if (fastb) xcd_barrier_local(bar); else xcd_barrier(bar); } } while (0)
    const int gw = vcu * NWAVES + wave, NGW = G * NWAVES, gtid = vcu * (NWAVES * 64) + tid, NGT = G * NWAVES * 64;

    if (IN(0)) {
        LAS float* ldsf = (LAS float*)lds;
        for (int blk = vcu; blk < 192; blk += G) {
            __syncthreads();
            const int col = tid & 15, ksl = tid >> 4, n = 16 * blk + col;
            float wv[32];
#pragma unroll
            for (int kk = 0; kk < 32; ++kk) wv[kk] = args.w_ada[(size_t)(ksl * 32 + kk) * 3072 + n];
            for (int i = tid; i < 8 * 1024; i += NWAVES * 64) ldsf[i] = siluf(args.c[i]);
            __syncthreads();
            float a[8];
#pragma unroll
            for (int b = 0; b < 8; ++b) a[b] = 0.f;
#pragma unroll
            for (int k4 = 0; k4 < 8; ++k4) {
#pragma unroll
                for (int b = 0; b < 8; ++b) { const f32x4 cv = *(const LAS f32x4*)(ldsf + b * 1024 + ksl * 32 + 4 * k4);
                    a[b] += (cv.x * wv[4 * k4] + cv.y * wv[4 * k4 + 1]) + (cv.z * wv[4 * k4 + 2] + cv.w * wv[4 * k4 + 3]); } }
            LAS float* red = ldsf + 8192;
#pragma unroll
            for (int b = 0; b < 8; ++b) red[(ksl * 8 + b) * 16 + col] = a[b];
            __syncthreads();
            if (tid < 128) { const int b = tid >> 4; float sacc = 0.f;
                for (int k2 = 0; k2 < 32; ++k2) sacc += red[(k2 * 8 + b) * 16 + col];
                ada[b * 3072 + n] = sacc + args.b_ada[n]; }
        }
        __syncthreads();
        LAS float* scr = (LAS float*)(lds + wave * 16384);
        constexpr int I_IN = 16 * (NIN / 32), I_A = 8 * 32, I_O = 16 * 32, NITEMS = I_IN + 2 * I_A + I_O;
        const bool p0bal = (G == 256); const int nslow = 192 * NWAVES, nfast = 64 * NWAVES;
        const int t_i0 = !p0bal ? gw : (gw < nslow ? gw : 2 * nslow + (gw - nslow)), t_st = !p0bal ? NGW : (gw < nslow ? nslow : nfast), t_end = !p0bal ? NITEMS : (gw < nslow ? 2 * nslow : NITEMS);
        for (int it = t_i0; it < t_end; it += t_st) {
            int r = it;
            if (r < I_IN) { const int kb = r / (NIN / 32), nb = r % (NIN / 32); const int np_ = 32 * nb, pn_ = tile_lt(np_ >> 8); transpose_item(args.w_in, 1024, NIN, win_t, win_srccol(np_), np_, 64 * kb, scr, lane, pn_ < 18 && ((pn_ % 6) >> 1) < 2 && ((np_ & 255) >> 7) == 0); continue; } r -= I_IN;
            if (r < I_A) { transpose_item(args.wa, 512, 1024, wa_t, 32 * (r % 32), 32 * (r % 32), 64 * (r / 32), scr, lane); continue; } r -= I_A;
            if (r < I_A) { transpose_item(args.wb, 512, 1024, wb_t, 32 * (r % 32), 32 * (r % 32), 64 * (r / 32), scr, lane); continue; } r -= I_A;
            transpose_item(args.wout, 1024, 1024, wout_t, 32 * (r % 32), 32 * (r % 32), 64 * (r / 32), scr, lane);
        }
        for (int i = gtid; i < 8 * 128 * 128 / 8; i += NGT) {
            const int e0 = i * 8, t = (e0 >> 7) & 127, s0 = e0 & 127; const f32x4 w0 = *(const f32x4*)(args.wsp + e0), w1 = *(const f32x4*)(args.wsp + e0 + 4);
            float v[8] = {w0[0], w0[1], w0[2], w0[3], w1[0], w1[1], w1[2], w1[3]};
#pragma unroll
            for (int j = 0; j < 8; ++j) v[j] = (s0 + j <= t) ? v[j] : 0.f;
            v4u o; o.x = pk2(v[0], v[1]); o.y = pk2(v[2], v[3]); o.z = pk2(v[4], v[5]); o.w = pk2(v[6], v[7]);
            *(v4u*)(wspb + e0) = o;
        }
        for (int i = gtid; i < MTOK * 8; i += NGT) {
            const int tok = i >> 3, fi = i & 7; const float freq = exp2f(-(float)fi * (18.931568569324174f / 8.f));
            const float ang = (float)args.pos[tok] * freq;
            const double ad = (double)ang; const double nrev = rint(ad * 0.15915494309189535); const float rr = (float)(ad - nrev * 6.283185307179586);
            rope[tok * 16 + fi] = cosf(rr); rope[tok * 16 + 8 + fi] = sinf(rr);
        }
        if (gtid < 3) { float mq = 0.f, mk = 0.f; for (int d = 0; d < 64; ++d) { mq = fmaxf(mq, fabsf(args.qg[gtid * 64 + d])); mk = fmaxf(mk, fabsf(args.kg[gtid * 64 + d])); }
            ref2tab[gtid] = 8.f * mq * mk * LOG2E * 1.03f + 0.25f; }
    }
    SEAM(0);
    if (N_LAUNCHES == 1 && G == 256) {
        if (tid == 0) { unsigned ok = 1u;
            for (int x = 0; x < 8; ++x) { const unsigned m = xb_ld((unsigned*)(ctl + CW_GRP + x)); ok &= (__builtin_popcount(m) == 1) ? 1u : 0u; }
            MISC[12] = ok; }
        __syncthreads();
        fastb = __builtin_amdgcn_readfirstlane((int)MISC[12]) != 0;
    }
    if (IN(1)) {
        for (int m0 = gw * 8; m0 < MTOK; m0 += NGW * 8) {
            const int b = m0 >> 11; f32x4 gm[4], sh[4], cur[4], nxt[4];
#pragma unroll
            for (int j = 0; j < 4; ++j) { const int k0 = 256 * j + 4 * lane;
                gm[j] = *(const f32x4*)(args.norm_g + k0) * (*(const f32x4*)(ada + b * 3072 + 1024 + k0) + 1.f); sh[j] = *(const f32x4*)(ada + b * 3072 + k0);
                cur[j] = ((const GAS f32x4*)(args.x + (size_t)m0 * DM) + lane)[64 * j]; }
#pragma unroll
            for (int r = 0; r < 8; ++r) {
                if (r < 7) {
#pragma unroll
                    for (int j = 0; j < 4; ++j) nxt[j] = ((const GAS f32x4*)(args.x + (size_t)(m0 + r + 1) * DM) + lane)[64 * j]; }
                float ss = 0.f;
#pragma unroll
                for (int j = 0; j < 4; ++j) ss += (cur[j].x * cur[j].x + cur[j].y * cur[j].y) + (cur[j].z * cur[j].z + cur[j].w * cur[j].w);
                const float rstd = __builtin_amdgcn_rsqf(wave_sum(ss) * (1.f / DM) + EPSN);
                GAS unsigned long long* o8 = (GAS unsigned long long*)(hbuf + (size_t)(m0 + r) * DM) + lane;
#pragma unroll
                for (int j = 0; j < 4; ++j) { const f32x4 hv = (cur[j] * rstd) * gm[j] + sh[j];
                    o8[64 * j] = (unsigned long long)pk2(hv.x, hv.y) | ((unsigned long long)pk2(hv.z, hv.w) << 32); }
#pragma unroll
                for (int j = 0; j < 4; ++j) cur[j] = nxt[j];
            }
        }
    }
    SEAML(1);
    const bool split9 = (G == 256); const bool late = split9 && bx < 128;
    const bool hook = late && fastb;
    if (IN(2)) {
        pg8::Gemm g{hbuf, win_t, MTOK, NZ2, DM}; RangeOrder S; S.S.init(MTOK, NZ2, G, bx); S.i0 = 0; S.n = split9 ? (hook ? 7 : 6) : 1 << 20;
        if (hook) { S.hook_after = 6; S.hb = bar; S.wcnt = MISC + 13; }
        if (split9) {
            pg8::Unit u0; S.next(0, u0);
            LAS f32x4* lr4 = (LAS f32x4*)(lds + LDS_ROPE); const f32x4* gr4 = (const f32x4*)(rope + (size_t)u0.pm * 256 * 16);
            for (int i = tid; i < 256 * 16 / 4; i += NWAVES * 64) lr4[i] = gr4[i];
            if (tid < 96) { const int e = tid * 4, gg = e >> 7, tt = (e >> 6) & 1, d = e & 63; ((LAS f32x4*)(lds + LDS_GAIN))[tid] = *(const f32x4*)((tt == 0 ? args.qg : args.kg) + gg * 64 + d); }
            LDS_WAIT(); __syncthreads();
            EpiZT<true> E{qkv, ga, ug, vg, ma, mb, stats, rope, args.qg, args.kg, (const LAS float*)(lds + LDS_ROPE), (const LAS float*)(lds + LDS_GAIN)};
            pg8::gemm_phase<EpiZT<true>, RangeOrder, true, true>(lds, g, S, E);
        } else {
            EpiZ E{qkv, ga, ug, vg, ma, mb, stats, rope, args.qg, args.kg};
            pg8::gemm_phase<EpiZ, RangeOrder, true, true>(lds, g, S, E);
        }
    }
    if (hook) { if (lo <= 2 && 3 < hi) xcd_local_wait(bar); } else SEAML(2);
    if (IN(3)) {
        if (late && !hook) {
            pg8::Gemm g{hbuf, win_t, MTOK, NZ2, DM}; RangeOrder S; S.S.init(MTOK, NZ2, G, bx); S.i0 = 6; S.n = 1;
            EpiZ E{qkv, ga, ug, vg, ma, mb, stats, rope, args.qg, args.kg};
            pg8::gemm_phase<EpiZ, RangeOrder, true, true>(lds, g, S, E);
        }
        if (split9) {
            const int grp = vcu >> 5, j = vcu & 31;
            const int a0 = grp * 384 + (j < 16 ? 9 * j : 144 + 15 * (j - 16)), cnt = j < 16 ? 9 : 15;
            att2::attn_phase(a0, cnt, qkv, lse, ref2tab, lds);
            const int i0 = grp * 128 + (j < 16 ? 3 * j : 48 + 5 * (j - 16)), ni = j < 16 ? 3 : 5;
            int i = 0;
            for (; i + 1 < ni; i += 2) gmlp_items2(i0 + i, i0 + i + 1, vg, ug, stats, wspb, args.bsp, args.lng, args.lnb, lds);
            if (i < ni) gmlp_item(i0 + i, vg, ug, stats, wspb, args.bsp, args.lng, args.lnb, lds);
        } else {
            const int per = (att2::NITEM + G - 1) / G, a0 = vcu * per, cnt = (att2::NITEM - a0) < per ? (att2::NITEM - a0) : per;
            att2::attn_phase(a0, cnt, qkv, lse, ref2tab, lds);
            int i = vcu;
            for (; i + G < 8 * 16 * 8; i += 2 * G) gmlp_items2(i, i + G, vg, ug, stats, wspb, args.bsp, args.lng, args.lnb, lds);
            if (i < 8 * 16 * 8) gmlp_item(i, vg, ug, stats, wspb, args.bsp, args.lng, args.lnb, lds);
        }
    }
    SEAML(3);
    if (IN(4)) {
#define P4_LOAD(IT, LS, OV, GV) do { const int tok_ = (IT) >> 6, h_ = ((IT) >> 3) & 7, j_ = (IT) & 7, b_ = tok_ >> 11, s_ = tok_ & 2047; \
            _Pragma("unroll") for (int g = 0; g < 3; ++g) { const int dsh = 2 * g, sp = ((s_ & ((1 << dsh) - 1)) << (11 - dsh)) + (s_ >> dsh); \
                LS[g] = lse[((size_t)(g * 8 + b_) * 8 + h_) * 2048 + sp]; \
                OV[g] = *(const v4u*)(qkv + ((size_t)(((b_ * 3 + g) * 3) * 8 + h_) * 2048 + sp) * 64 + j_ * 8); } \
            GV = *(const v4u*)(ga + (size_t)tok_ * 512 + h_ * 64 + j_ * 8); } while (0)
        constexpr int NIT4 = MTOK * 64;
        const int p4_i0 = split9 ? (vcu >> 5) * (2048 * 64) + (vcu & 31) * (NWAVES * 64) + tid : gtid, p4_st = split9 ? 32 * NWAVES * 64 : NGT, p4_end = split9 ? ((vcu >> 5) + 1) * (2048 * 64) : NIT4;
        float lsA[3], lsB[3], lsC[3]; v4u ovA[3], ovB[3], ovC[3]; v4u gvA, gvB, gvC;
#define CMB(f, OV, GV) { const float a0 = (w0 * bflo(OV[0].f) + w1 * bflo(OV[1].f)) + w2 * bflo(OV[2].f), a1 = (w0 * bfhi(OV[0].f) + w1 * bfhi(OV[1].f)) + w2 * bfhi(OV[2].f); o.f = pg8::cvt_pk_bf16(a0 * bflo(GV.f), a1 * bfhi(GV.f)); }
#define P4_STEP(IT, LS, OV, GV, LSN, OVN, GVN) do { const int it_ = (IT); \
            { const int itn_ = it_ + 2 * p4_st < p4_end ? it_ + 2 * p4_st : p4_end - 1; P4_LOAD(itn_, LSN, OVN, GVN); }     \
            const int tok = it_ >> 6, h = (it_ >> 3) & 7, j = it_ & 7; \
            const float mx = fmaxf(fmaxf(LS[0], LS[1]), LS[2]); \
            float w0 = __builtin_amdgcn_exp2f((LS[0] - mx) * LOG2E), w1 = __builtin_amdgcn_exp2f((LS[1] - mx) * LOG2E), w2 = __builtin_amdgcn_exp2f((LS[2] - mx) * LOG2E); \
            const float inv = __builtin_amdgcn_rcpf(w0 + w1 + w2); w0 *= inv; w1 *= inv; w2 *= inv; \
            v4u o; CMB(x, OV, GV) CMB(y, OV, GV) CMB(z, OV, GV) CMB(w, OV, GV) \
            asm volatile("" ::: "memory"); \
            if (it_ < p4_end) *(v4u*)(ga + (size_t)tok * 512 + h * 64 + j * 8) = o; } while (0)
        { const int i0_ = p4_i0 < p4_end ? p4_i0 : p4_end - 1, i1_ = p4_i0 + p4_st < p4_end ? p4_i0 + p4_st : p4_end - 1; P4_LOAD(i0_, lsA, ovA, gvA); P4_LOAD(i1_, lsB, ovB, gvB); }
        for (int it = p4_i0; it < p4_end; it += 3 * p4_st) {
            P4_STEP(it, lsA, ovA, gvA, lsC, ovC, gvC);
            P4_STEP(it + p4_st, lsB, ovB, gvB, lsA, ovA, gvA);
            P4_STEP(it + 2 * p4_st, lsC, ovC, gvC, lsB, ovB, gvB);
        }
#undef P4_STEP
#undef CMB
#undef P4_LOAD
    }
    SEAML(4);
    if (IN(5)) {
        { pg8::Gemm gz{hbuf, win_t, MTOK, NIN, DM}; MergeOrder Sz{G, bx};
          EpiZ Ez{qkv, ga, ug, vg, ma, mb, stats, rope, args.qg, args.kg};
          pg8::gemm_phase<EpiZ, MergeOrder, true, true>(lds, gz, Sz, Ez); }
        pg8::Gemm g{ga, wa_t, 2 * MTOK, 2048, 512}; PairOrder S{G, bx};
        EpiMrg E{ma, mb, merged};
        pg8::gemm_phase<EpiMrg, PairOrder, true, true>(lds, g, S, E);
    }
    SEAML(5);
    if (IN(6)) {
        pg8::Gemm g{merged, wout_t, MTOK, DM, DM, (OVL_BSTR - (size_t)2048 * 1024) * 2}; pg8::StaticOrder S; S.init(MTOK, DM, G, bx);
        EpiOut E{args.x, ada, args.out};
        pg8::gemm_phase<EpiOut, pg8::StaticOrder, true, true>(lds, g, S, E);
    }

    if (N_LAUNCHES != 1) { asm volatile("s_waitcnt vmcnt(0)" ::: "memory"); __builtin_amdgcn_fence(__ATOMIC_RELEASE, "agent"); asm volatile("s_waitcnt vmcnt(0)" ::: "memory"); }
#undef IN
#undef SEAM
#undef SEAML
}

extern "C" void kernel_launch(void* const* d_in, const int* in_sizes, int n_in, void* d_out, int out_size, void* d_ws, size_t ws_size, hipStream_t stream) {
    static int grid = 0;
    if (grid == 0) {
        if (n_in != 16 || in_sizes[0] != MTOK * DM || out_size != MTOK * DM || ws_size < WS_END) { fprintf(stderr, "kernel_launch: unexpected shapes (n_in %d, in0 %d, out %d, ws %zu); nothing launched\n", n_in, n_in > 0 ? in_sizes[0] : -1, out_size, ws_size); grid = -1; return; }
        int dev = 0, cus = 0, per_cu = 0;
        if (hipGetDevice(&dev) != hipSuccess || hipDeviceGetAttribute(&cus, hipDeviceAttributeMultiprocessorCount, dev) != hipSuccess) { fprintf(stderr, "kernel_launch: device query failed\n"); grid = -1; return; }
        if (hipFuncSetAttribute((const void*)fwd_kernel, hipFuncAttributeMaxDynamicSharedMemorySize, LDS_BYTES) != hipSuccess) { fprintf(stderr, "kernel_launch: hipFuncSetAttribute failed\n"); grid = -1; return; }
        if (hipOccupancyMaxActiveBlocksPerMultiprocessor(&per_cu, (const void*)fwd_kernel, NWAVES * 64, LDS_BYTES) != hipSuccess || per_cu < 1) { fprintf(stderr, "kernel_launch: occupancy query says %d workgroups per CU\n", per_cu); per_cu = 1; }
        (void)hipGetLastError();
        grid = cus;
    }
    if (grid < 0) return;
    if (hipMemsetAsync((char*)d_ws + WS_CTL, 0, CTL_ZERO_BYTES, stream) != hipSuccess) { fprintf(stderr, "kernel_launch: memset failed\n"); return; }
    Args a{};
    a.x = (const float*)d_in[0]; a.c = (const float*)d_in[1]; a.pos = (const int*)d_in[2]; a.norm_g = (const float*)d_in[3]; a.w_ada = (const float*)d_in[4]; a.b_ada = (const float*)d_in[5];
    a.w_in = (const float*)d_in[6]; a.qg = (const float*)d_in[7]; a.kg = (const float*)d_in[8]; a.lng = (const float*)d_in[9]; a.lnb = (const float*)d_in[10]; a.wsp = (const float*)d_in[11];
    a.bsp = (const float*)d_in[12]; a.wa = (const float*)d_in[13]; a.wb = (const float*)d_in[14]; a.wout = (const float*)d_in[15];
    a.out = (float*)d_out; a.ws = (unsigned char*)d_ws;
    const int nl = N_LAUNCHES;
    for (int li = 0; li < nl; ++li) {
        a.ph_lo = (N_LAUNCHES == 1) ? 0 : li; a.ph_hi = (N_LAUNCHES == 1) ? N_PHASES : li + 1; a.li = li;
        hipLaunchKernelGGL(fwd_kernel, dim3(grid), dim3(NWAVES * 64), LDS_BYTES, stream, a);
        const hipError_t le = hipPeekAtLastError();
        if (le != hipSuccess) { fprintf(stderr, "kernel_launch: launch %d failed: %s\n", li, hipGetErrorName(le)); break; }
    }
}
```
